# Optimizing an MI355X kernel written in HIP

```python
import jax, jax.numpy as jnp
from jax import lax
import numpy as np

D_MODEL = 1024
BATCH = 8
SEQ = 8192
DEPTH = 1
DEC_BATCH = 16
DEC_SEQ = 2048
PAST_LEN = 128

MLA_HEADS = 8
QK_NOPE = 64
QK_ROPE = 32
V_HEAD = 64
Q_LORA = 384
KV_LORA = 256
MLA_WIDTH = MLA_HEADS * V_HEAD
ROPE_BASE = 10000.0
Q_BLOCK = 128
RWKV_HEADS = 8
RWKV_HEAD = 64
RWKV_WIDTH = RWKV_HEADS * RWKV_HEAD
DECAY_LORA = 64
ICLR_LORA = 64
GATE_LORA = 128
N_BRANCH = 2
D_FF = ((8 * D_MODEL // 3 + 255) // 256) * 256
EPS = 1e-6
LNX_EPS = 64e-5
MLA_IN = Q_LORA + KV_LORA + QK_ROPE
RWKV_IN = 3 * RWKV_WIDTH + DECAY_LORA + ICLR_LORA + GATE_LORA
GATE_IN = N_BRANCH * D_MODEL
IN_COLS = MLA_IN + RWKV_IN + GATE_IN

kernel_name = "hybrid_mla_rwkv7_adaln_encoder"


def rmsnorm(x, g):
    xf = x.astype(jnp.float32)
    y = xf * lax.rsqrt(jnp.mean(xf * xf, axis=-1, keepdims=True) + EPS)
    return (y * g.astype(jnp.float32)).astype(x.dtype)


def rope_tables(T):
    half = QK_ROPE // 2
    inv = ROPE_BASE ** (-jnp.arange(half, dtype=jnp.float32) / half)
    ang = jnp.arange(T, dtype=jnp.float32)[:, None] * inv[None, :]
    return jnp.cos(ang), jnp.sin(ang)


def apply_rope(x, cos, sin):
    xf = x.astype(jnp.float32)
    x1, x2 = jnp.split(xf, 2, axis=-1)
    return jnp.concatenate([x1 * cos - x2 * sin, x2 * cos + x1 * sin], axis=-1).astype(x.dtype)


def centred_shift(p):
    pad = jnp.pad(p, ((0, 0), (1, 1), (0, 0)))
    return 0.5 * (pad[:, :-2] + pad[:, 2:])


def block_attention(q, k, v):
    B, T, H, dqk = q.shape
    scale = dqk ** -0.5
    nblk = T // Q_BLOCK
    qb = q.reshape(B, nblk, Q_BLOCK, H, dqk).transpose(1, 0, 2, 3, 4)

    def one_block(qblk):
        s = jnp.einsum('bqhd,bkhd->bhqk', qblk, k).astype(jnp.float32) * scale
        pr = jax.nn.softmax(s, axis=-1).astype(v.dtype)
        return jnp.einsum('bhqk,bkhd->bqhd', pr, v)

    out = lax.map(one_block, qb)
    return out.transpose(1, 0, 2, 3, 4).reshape(B, T, H * v.shape[-1])


def mla_branch(p_mla, q_a_norm, kv_a_norm, w_uq, w_ukv):
    B, T, _ = p_mla.shape
    cq = rmsnorm(p_mla[..., :Q_LORA], q_a_norm)
    ckv = rmsnorm(p_mla[..., Q_LORA:Q_LORA + KV_LORA], kv_a_norm)
    k_pe = p_mla[..., Q_LORA + KV_LORA:]
    q = (cq @ w_uq).reshape(B, T, MLA_HEADS, QK_NOPE + QK_ROPE)
    kv = (ckv @ w_ukv).reshape(B, T, MLA_HEADS, QK_NOPE + V_HEAD)
    q_nope, q_pe = q[..., :QK_NOPE], q[..., QK_NOPE:]
    k_nope, v = kv[..., :QK_NOPE], kv[..., QK_NOPE:]
    cos, sin = rope_tables(T)
    q_pe = apply_rope(q_pe, cos[:, None, :], sin[:, None, :])
    k_pe = apply_rope(k_pe, cos, sin)
    q = jnp.concatenate([q_nope, q_pe], axis=-1)
    k = jnp.concatenate([k_nope, jnp.broadcast_to(k_pe[:, :, None, :], (B, T, MLA_HEADS, QK_ROPE))], axis=-1)
    return block_attention(q, k, v)


def wkv_scan(r, w, k, v, kk, a, reverse):
    B, T, H, N = r.shape
    xs = tuple(t.transpose(1, 0, 2, 3) for t in (r, w, k, v, kk, a))

    def step(S, inp):
        r_t, w_t, k_t, v_t, kk_t, a_t = inp
        sa = jnp.einsum('bhvk,bhk->bhv', S, -kk_t)
        S = (S * w_t[:, :, None, :]
             + sa[..., :, None] * (kk_t * a_t)[..., None, :]
             + v_t[..., :, None] * k_t[..., None, :])
        y = jnp.einsum('bhvk,bhk->bhv', S, r_t)
        return S, y

    S0 = jnp.zeros((B, H, N, N), jnp.float32)
    _, ys = lax.scan(step, S0, xs, reverse=reverse)
    return ys.transpose(1, 0, 2, 3)


def rwkv_branch(p_rwkv, mu_shift, w0, w_decay_up, a0, w_iclr_up, w_gate_up, k_k, k_a, r_k, lnx_w, lnx_b):
    B, T, _ = p_rwkv.shape
    pf = p_rwkv.astype(jnp.float32)
    xs = pf + mu_shift.astype(jnp.float32) * (centred_shift(pf) - pf)
    W = RWKV_WIDTH
    r = xs[..., :W]
    k = xs[..., W:2 * W]
    v = xs[..., 2 * W:3 * W]
    wd = xs[..., 3 * W:3 * W + DECAY_LORA]
    ad = xs[..., 3 * W + DECAY_LORA:3 * W + DECAY_LORA + ICLR_LORA]
    gd = xs[..., 3 * W + DECAY_LORA + ICLR_LORA:]
    f32 = lambda t: t.astype(jnp.float32)
    g = jax.nn.sigmoid(gd) @ f32(w_gate_up)
    heads = lambda t: t.reshape(B, T, RWKV_HEADS, RWKV_HEAD)
    kk = heads(k * f32(k_k))
    kk = kk * lax.rsqrt(jnp.sum(kk * kk, axis=-1, keepdims=True) + 1e-12)
    tw = jnp.tanh(wd)
    rh, vh = heads(r), heads(v)
    y = jnp.zeros((B, T, RWKV_HEADS, RWKV_HEAD), jnp.float32)
    bonus_k = jnp.zeros((B, T, RWKV_HEADS, RWKV_HEAD), jnp.float32)
    for d in range(2):
        wlog = -jax.nn.softplus(-(f32(w0[d]) + tw @ f32(w_decay_up[d]))) - 0.5
        decay = jnp.exp(-jnp.exp(wlog))
        a = jax.nn.sigmoid(f32(a0[d]) + ad @ f32(w_iclr_up[d]))
        k_d = k * (1.0 + (a - 1.0) * f32(k_a))
        y = y + wkv_scan(rh, heads(decay), heads(k_d), vh, kk, heads(a), reverse=(d == 1))
        bonus_k = bonus_k + heads(k_d)
    mu = jnp.mean(y, axis=-1, keepdims=True)
    var = jnp.mean(jnp.square(y - mu), axis=-1, keepdims=True)
    yn = ((y - mu) * lax.rsqrt(var + LNX_EPS)).reshape(B, T, W) * f32(lnx_w) + f32(lnx_b)
    bonus = jnp.sum(rh * bonus_k * f32(r_k), axis=-1, keepdims=True) * vh
    out = (yn + bonus.reshape(B, T, W)) * g
    return out.astype(p_rwkv.dtype)


def encoder(x, c, w_ada, b_ada, norm_mix, w_in, q_a_norm, kv_a_norm, w_uq, w_ukv,
            mu_shift, w0, w_decay_up, a0, w_iclr_up, w_gate_up, k_k, k_a, r_k, lnx_w, lnx_b,
            w_mla_o, w_rwkv_o, w_out, norm_ffn, w_ffn_in, w_ffn_out, final_norm):
    for l in range(DEPTH):
        mod = jax.nn.silu(c) @ w_ada[l] + b_ada[l]
        sh1, sc1, g1, sh2, sc2, g2 = jnp.split(mod[:, None, :], 6, axis=-1)
        h = rmsnorm(x, norm_mix[l]) * (1.0 + sc1) + sh1
        p = h @ w_in[l]
        p_mla = p[..., :MLA_IN]
        p_rwkv = p[..., MLA_IN:MLA_IN + RWKV_IN]
        p_gate = p[..., MLA_IN + RWKV_IN:]
        o_mla = mla_branch(p_mla, q_a_norm[l], kv_a_norm[l], w_uq[l], w_ukv[l]) @ w_mla_o[l]
        o_rwkv = rwkv_branch(p_rwkv, mu_shift[l], w0[l], w_decay_up[l], a0[l], w_iclr_up[l],
                             w_gate_up[l], k_k[l], k_a[l], r_k[l], lnx_w[l], lnx_b[l]) @ w_rwkv_o[l]
        gm, gr = jnp.split(jax.nn.sigmoid(p_gate), 2, axis=-1)
        x = x + g1 * ((gm * o_mla + gr * o_rwkv) @ w_out[l])
        h = rmsnorm(x, norm_ffn[l]) * (1.0 + sc2) + sh2
        u, z = jnp.split(h @ w_ffn_in[l], 2, axis=-1)
        x = x + g2 * ((jax.nn.silu(u) * z) @ w_ffn_out[l])
    return rmsnorm(x, final_norm)


def setup_inputs(seed: int = 0) -> dict:
    key = jax.random.key(seed)
    ks = jax.random.split(key, 32)
    L = DEPTH

    def nrm(k, shape, scale):
        return jax.random.normal(k, shape, jnp.float32) * scale

    def gain(k, shape):
        return 1.0 + nrm(k, shape, 0.02)

    w0_base = jnp.linspace(-6.0, -1.0, RWKV_WIDTH, dtype=jnp.float32)
    return {
        "x_prompt": nrm(ks[0], (BATCH, SEQ, D_MODEL), 1.0),
        "x_sample": nrm(ks[1], (DEC_BATCH, DEC_SEQ, D_MODEL), 1.0),
        "c_prompt": nrm(ks[2], (BATCH, D_MODEL), 1.0),
        "c_sample": nrm(ks[3], (DEC_BATCH, D_MODEL), 1.0),
        "w_ada": nrm(ks[4], (L, D_MODEL, 6 * D_MODEL), 0.5 * D_MODEL ** -0.5),
        "b_ada": nrm(ks[5], (L, 6 * D_MODEL), 0.01),
        "norm_mix": gain(ks[6], (L, D_MODEL)),
        "w_in": nrm(ks[7], (L, D_MODEL, IN_COLS), D_MODEL ** -0.5),
        "q_a_norm": gain(ks[8], (L, Q_LORA)),
        "kv_a_norm": gain(ks[9], (L, KV_LORA)),
        "w_uq": nrm(ks[10], (L, Q_LORA, MLA_HEADS * (QK_NOPE + QK_ROPE)), Q_LORA ** -0.5),
        "w_ukv": nrm(ks[11], (L, KV_LORA, MLA_HEADS * (QK_NOPE + V_HEAD)), KV_LORA ** -0.5),
        "mu_shift": jax.random.uniform(ks[12], (L, RWKV_IN), jnp.float32, 0.0, 1.0),
        "w0": w0_base[None, None, :] + nrm(ks[13], (L, 2, RWKV_WIDTH), 0.1),
        "w_decay_up": nrm(ks[14], (L, 2, DECAY_LORA, RWKV_WIDTH), 0.1 * DECAY_LORA ** -0.5),
        "a0": nrm(ks[15], (L, 2, RWKV_WIDTH), 0.1),
        "w_iclr_up": nrm(ks[16], (L, 2, ICLR_LORA, RWKV_WIDTH), ICLR_LORA ** -0.5),
        "w_gate_up": nrm(ks[17], (L, GATE_LORA, RWKV_WIDTH), GATE_LORA ** -0.5),
        "k_k": 0.85 + nrm(ks[18], (L, RWKV_WIDTH), 0.05),
        "k_a": 1.0 + nrm(ks[19], (L, RWKV_WIDTH), 0.05),
        "r_k": nrm(ks[20], (L, RWKV_HEADS, RWKV_HEAD), 0.1),
        "lnx_w": gain(ks[21], (L, RWKV_WIDTH)),
        "lnx_b": nrm(ks[22], (L, RWKV_WIDTH), 0.01),
        "w_mla_o": nrm(ks[23], (L, MLA_WIDTH, D_MODEL), MLA_WIDTH ** -0.5),
        "w_rwkv_o": nrm(ks[24], (L, RWKV_WIDTH, D_MODEL), RWKV_WIDTH ** -0.5),
        "w_out": nrm(ks[25], (L, D_MODEL, D_MODEL), D_MODEL ** -0.5),
        "norm_ffn": gain(ks[26], (L, D_MODEL)),
        "w_ffn_in": nrm(ks[27], (L, D_MODEL, 2 * D_FF), D_MODEL ** -0.5),
        "w_ffn_out": nrm(ks[28], (L, D_FF, D_MODEL), D_FF ** -0.5),
        "final_norm": gain(ks[29], (D_MODEL,)),
    }


def reference(x_prompt, x_sample, c_prompt, c_sample, w_ada, b_ada, norm_mix, w_in, q_a_norm,
              kv_a_norm, w_uq, w_ukv, mu_shift, w0, w_decay_up, a0, w_iclr_up, w_gate_up, k_k,
              k_a, r_k, lnx_w, lnx_b, w_mla_o, w_rwkv_o, w_out, norm_ffn, w_ffn_in, w_ffn_out,
              final_norm):
    weights = (w_ada, b_ada, norm_mix, w_in, q_a_norm, kv_a_norm, w_uq, w_ukv, mu_shift, w0,
               w_decay_up, a0, w_iclr_up, w_gate_up, k_k, k_a, r_k, lnx_w, lnx_b, w_mla_o,
               w_rwkv_o, w_out, norm_ffn, w_ffn_in, w_ffn_out, final_norm)
    y_prompt = encoder(x_prompt, c_prompt, *weights)
    y_sample = encoder(x_sample, c_sample, *weights)
    return (y_prompt, y_sample)
```

```cpp
#include <hip/hip_runtime.h>
#include <hip/hip_cooperative_groups.h>
#include <cstdio>
#include <cstdint>
namespace cg = cooperative_groups;

#define LAS __attribute__((address_space(3)))
typedef unsigned short bf16_t;
typedef short bf16x8 __attribute__((ext_vector_type(8)));
typedef float f32x4 __attribute__((ext_vector_type(4)));
typedef float f32x2 __attribute__((ext_vector_type(2)));
typedef float f32x16 __attribute__((ext_vector_type(16)));
typedef unsigned u32x4 __attribute__((ext_vector_type(4)));
typedef unsigned u32x2 __attribute__((ext_vector_type(2)));

constexpr int DM = 1024, MP = 65536, MS = 32768, MT = MP + MS;
constexpr int TP = 8192, TS = 2048, NSEQ = 24;
constexpr int NPAD_IN = 4608, DFF = 2816;
constexpr float EPS = 1e-6f, LNX_EPS = 64e-5f;
constexpr float QSCALE = 0.10206207261596575f * 1.4426950408889634f;

constexpr size_t MiB = 1u << 20;
constexpr size_t WS_MOD = 0, WS_ROPE = 1 * MiB;
constexpr size_t WS_WIN = 2 * MiB, WS_WUQ = 11 * MiB, WS_WK = 12 * MiB, WS_WV = WS_WK + 512 * 1024, WS_WG = 13 * MiB, WS_WMO = 14 * MiB, WS_WRO = 15 * MiB,
                 WS_WOUT = 16 * MiB, WS_WFFI = 18 * MiB, WS_WFFO = 29 * MiB;
constexpr size_t WS_SSQ = 35 * MiB;
constexpr size_t WS_KPE = 43 * MiB;
constexpr size_t WS_BIG = 50 * MiB;
constexpr size_t WS_XN = WS_BIG, WS_Q = WS_BIG, WS_Y0 = WS_BIG, WS_XN2 = WS_BIG;
constexpr size_t WS_T1A = WS_BIG + 96 * MiB, WS_T1B = WS_BIG + 744 * MiB;
constexpr size_t WS_PM = WS_BIG + 192 * MiB, WS_G = WS_PM, WS_TA = WS_PM + 96 * MiB;
constexpr size_t WS_PR = WS_BIG + 312 * MiB, WS_MIX = WS_PR;
constexpr size_t WS_KN = WS_BIG + 648 * MiB, WS_VT = WS_KN + 96 * MiB, WS_Y1 = WS_KN;
constexpr size_t WS_O = WS_BIG + 840 * MiB;
constexpr size_t WS_SG = WS_BIG + 936 * MiB;
constexpr size_t WS_BON = WS_BIG + 960 * MiB;
constexpr size_t WS_H = WS_BIG + 384 * MiB;
constexpr size_t WS_BAR = 1016 * MiB;
constexpr size_t WS_SSQ2 = 1017 * MiB;
constexpr size_t WS_C2 = 1018 * MiB;
constexpr size_t WS_END = 1019 * MiB;

__device__ __forceinline__ unsigned cvtpk(float lo, float hi) { typedef __bf16 bf2 __attribute__((ext_vector_type(2))); f32x2 v = {lo, hi}; bf2 b = __builtin_convertvector(v, bf2); return __builtin_bit_cast(unsigned, b); }
__device__ __forceinline__ float bflo(unsigned w) { return __uint_as_float(w << 16); }
__device__ __forceinline__ float bfhi(unsigned w) { return __uint_as_float(w & 0xffff0000u); }
__device__ __forceinline__ float bf2f(bf16_t u) { return __uint_as_float((unsigned)u << 16); }
__device__ __forceinline__ u32x4 pack8(f32x4 a, f32x4 b) { u32x4 w; w.x = cvtpk(a[0], a[1]); w.y = cvtpk(a[2], a[3]); w.z = cvtpk(b[0], b[1]); w.w = cvtpk(b[2], b[3]); return w; }
__device__ __forceinline__ void unpack8(u32x4 w, f32x4& a, f32x4& b) { a = (f32x4){bflo(w.x), bfhi(w.x), bflo(w.y), bfhi(w.y)}; b = (f32x4){bflo(w.z), bfhi(w.z), bflo(w.w), bfhi(w.w)}; }
__device__ __forceinline__ float wave_sum(float v) {
#pragma unroll
    for (int o = 1; o < 64; o <<= 1) v += __shfl_xor(v, o);
    return v;
}
__device__ __forceinline__ float max3f(float a, float b, float c) { float r; asm("v_max3_f32 %0, %1, %2, %3" : "=v"(r) : "v"(a), "v"(b), "v"(c)); return r; }
template <int CTRL> __device__ __forceinline__ float dpp_f(float x) { return __int_as_float(__builtin_amdgcn_update_dpp(0, __float_as_int(x), CTRL, 0xf, 0xf, true)); }
__device__ __forceinline__ float sum8(float x) { x += dpp_f<0xB1>(x); x += dpp_f<0x4E>(x); x += dpp_f<0x141>(x); return x; }
__device__ __forceinline__ float sum64q(float x) {
    x += dpp_f<0xB1>(x); x += dpp_f<0x4E>(x); x += dpp_f<0x141>(x); x += dpp_f<0x140>(x);
    return __int_as_float(__builtin_amdgcn_readlane(__float_as_int(x), 0)) + __int_as_float(__builtin_amdgcn_readlane(__float_as_int(x), 16)) + __int_as_float(__builtin_amdgcn_readlane(__float_as_int(x), 32)) + __int_as_float(__builtin_amdgcn_readlane(__float_as_int(x), 48)); }
__device__ __forceinline__ float sum_rows4(float x) {
    auto r16 = __builtin_amdgcn_permlane16_swap(__float_as_uint(x), __float_as_uint(x), false, false); x = __uint_as_float(r16[0]) + __uint_as_float(r16[1]);
    auto r32 = __builtin_amdgcn_permlane32_swap(__float_as_uint(x), __float_as_uint(x), false, false); return __uint_as_float(r32[0]) + __uint_as_float(r32[1]); }
__device__ __forceinline__ float tanh_fast(float x) { const float e = __expf(2.0f * x); return 1.0f - 2.0f * __builtin_amdgcn_rcpf(1.0f + e); }
__device__ __forceinline__ float sigmoidf_(float x) { return __builtin_amdgcn_rcpf(1.0f + __expf(-x)); }
__device__ __forceinline__ int seq_of_row(int row) { return row < MP ? (row >> 13) : 8 + ((row - MP) >> 11); }
__device__ __forceinline__ int pos_of_row(int row) { return row < MP ? (row & (TP - 1)) : (row & (TS - 1)); }
__device__ __forceinline__ int len_of_row(int row) { return row < MP ? TP : TS; }

namespace pg8 {
constexpr int BM = 256, BK = 64, HALF = 128, HTB = HALF * BK * 2, STAGE_BYTES = 8 * HTB, NXCD = 8, WGM = 8;
__host__ __device__ __forceinline__ int lds_byte(int r, int c) { const int st = (r >> 4) * 2 + (c >> 5), rr = r & 15, cc = c & 31, ob = rr * 64 + cc * 2; return st * 1024 + (ob ^ (((ob >> 9) & 1) << 5)); }
__host__ __device__ __forceinline__ void stage_rc(int b, int& R, int& C) { const int st = b / 1024, sb = b % 1024, swz = sb ^ (((sb >> 9) & 1) << 5); R = (st >> 1) * 16 + swz / 64; C = (st & 1) * 32 + (swz % 64) / 2; }
__host__ __device__ __forceinline__ int perm32(int rho) { const int n = rho >> 4, i = rho & 15; return 8 * (i >> 2) + 4 * n + (i & 3); }
struct Unit { int pm, pn; };
struct Gemm { const bf16_t* A; const bf16_t* Bt; int M, N, K, lda, ldb; };
struct StaticOrder {
    int nM, nN, nwg, G, c;
    __device__ void init(int M, int N, int G_, int c_) { nM = M / BM; nN = N / BM; nwg = nM * nN; G = G_; c = c_; }
    __device__ bool next(int i, Unit& u) const {
        const long L = (long)i * G + c; if (L >= nwg) return false;
        int wgid = (int)L; { const int q = nwg / NXCD, r = nwg % NXCD, xcd = wgid % NXCD, off = wgid / NXCD; wgid = (xcd < r ? xcd * (q + 1) : r * (q + 1) + (xcd - r) * q) + off; }
        const int nig = WGM * nN, gid = wgid / nig, fm = gid * WGM, gsz = (nM - fm) < WGM ? (nM - fm) : WGM;
        u.pm = fm + ((wgid % nig) % gsz); u.pn = (wgid % nig) / gsz; return true;
    }
};
template <class Epi, bool ALIGN_EPI>
__device__ __forceinline__ void gemm_phase(LAS unsigned char* lds, const Gemm g, const StaticOrder& S, const Epi& E) {
    int tid = threadIdx.x; asm volatile("" : "+v"(tid));
    const int wid = __builtin_amdgcn_readfirstlane(tid >> 6), lane = tid & 63, wr = wid >> 2, wc = wid & 3, fr = lane & 15, fq = lane >> 4;
    const int K = g.K, nt = K / BK;
    unsigned voffA[2], voffB[2];
#pragma unroll
    for (int i = 0; i < 2; ++i) { int R, C; stage_rc(tid * 16 + i * 8192, R, C); const int Rb = (R & ~31) + perm32(R & 31);
        voffA[i] = (unsigned)(R * g.lda + C) * 2u; voffB[i] = (unsigned)(Rb * g.ldb + C) * 2u; }
    const size_t kstep = (size_t)(BK * 2);
    const size_t hstepA = (size_t)HALF * g.lda * 2, hstepB = (size_t)HALF * g.ldb * 2;
    const size_t tstepA = 2 * hstepA, tstepB = 2 * hstepB;
    const unsigned ldsw = (unsigned)wid * 1024u;
    const int aoff = lds_byte(wr * 64 + fr, fq * 8), boff = lds_byte(wc * 32 + fr, fq * 8);
#define PG8_SA(b, h) (((b) * 2 + (h)) * HTB)
#define PG8_SB(b, h) ((4 + (b) * 2 + (h)) * HTB)
#define PG8_STAGE(bufoff, gbase, voff) do { _Pragma("unroll") for (int _i = 0; _i < 2; ++_i) \
        __builtin_amdgcn_global_load_lds((const unsigned*)((const char*)(gbase) + (voff)[_i]), (LAS unsigned*)(lds + (bufoff) + ldsw + _i * 8192), 16, 0, 0); } while (0)
#define PG8_LDA(dst, b, h) do { _Pragma("unroll") for (int m = 0; m < 4; ++m) _Pragma("unroll") for (int k = 0; k < 2; ++k) dst[m][k] = *(const LAS bf16x8*)(lds + PG8_SA(b, h) + aoff + m * 2048 + k * 1024); } while (0)
#define PG8_LDB(dst, b, h) do { _Pragma("unroll") for (int n = 0; n < 2; ++n) _Pragma("unroll") for (int k = 0; k < 2; ++k) dst[n][k] = *(const LAS bf16x8*)(lds + PG8_SB(b, h) + boff + n * 2048 + k * 1024); } while (0)
#define PG8_MMA(ai, bj, At, Bt) do { __builtin_amdgcn_s_setprio(1); _Pragma("unroll") for (int m = 0; m < 4; ++m) _Pragma("unroll") for (int n = 0; n < 2; ++n) _Pragma("unroll") for (int k = 0; k < 2; ++k) \
        acc[ai][bj][m][n] = __builtin_amdgcn_mfma_f32_16x16x32_bf16(Bt[n][k], At[m][k], acc[ai][bj][m][n], 0, 0, 0); __builtin_amdgcn_s_setprio(0); } while (0)
#define PG8_WAIT_V(n) asm volatile("s_waitcnt vmcnt(" #n ")" ::: "memory")
#define PG8_WAIT_L(n) asm volatile("s_waitcnt lgkmcnt(" #n ")" ::: "memory")
#define PG8_BAR __builtin_amdgcn_s_barrier()
#define PG8_SCHED __builtin_amdgcn_sched_barrier(0)
    Unit cur, nxt; int ui = 0;
    if (!S.next(0, cur)) return;
    f32x4 acc[2][2][4][2];
#pragma unroll
    for (int a = 0; a < 2; ++a)
#pragma unroll
        for (int b = 0; b < 2; ++b)
#pragma unroll
            for (int m = 0; m < 4; ++m)
#pragma unroll
                for (int n = 0; n < 2; ++n) acc[a][b][m][n] = (f32x4){0.f, 0.f, 0.f, 0.f};
    bf16x8 At[4][2], B0[2][2], B1[2][2];
    const char* cA = (const char*)g.A + (size_t)cur.pm * tstepA; const char* cB = (const char*)g.Bt + (size_t)cur.pn * tstepB;
    PG8_STAGE(PG8_SB(0, 0), cB, voffB); PG8_STAGE(PG8_SB(0, 1), cB + hstepB, voffB); PG8_STAGE(PG8_SA(0, 0), cA, voffA); PG8_STAGE(PG8_SA(0, 1), cA + hstepA, voffA);
    if (wr == 1) PG8_BAR;
    PG8_WAIT_V(2); PG8_BAR;
    PG8_STAGE(PG8_SB(1, 0), cB + kstep, voffB); PG8_STAGE(PG8_SA(1, 0), cA + kstep, voffA); PG8_STAGE(PG8_SB(1, 1), cB + hstepB + kstep, voffB);
    PG8_WAIT_V(6); PG8_BAR;
    for (;;) {
        const bool has_next = S.next(ui + 1, nxt);
        const char* nA = has_next ? (const char*)g.A + (size_t)nxt.pm * tstepA : cA; const char* nB = has_next ? (const char*)g.Bt + (size_t)nxt.pn * tstepB : cB;
        for (int t = 0; t < nt; t += 2) {
            const bool last = (t == nt - 2);
            const char* a1 = cA + (size_t)(t + 1) * kstep;
            const char* a2 = last ? nA : cA + (size_t)(t + 2) * kstep; const char* b2 = last ? nB : cB + (size_t)(t + 2) * kstep;
            const char* a3 = a2 + kstep; const char* b3 = b2 + kstep;
            PG8_LDB(B0, 0, 0); PG8_LDB(B1, 0, 1); PG8_SCHED; PG8_LDA(At, 0, 0); PG8_STAGE(PG8_SA(1, 1), a1 + hstepA, voffA);
            PG8_WAIT_V(8); PG8_WAIT_L(0); PG8_BAR; PG8_MMA(0, 0, At, B0); PG8_MMA(0, 1, At, B1); PG8_BAR; PG8_SCHED;
            PG8_LDA(At, 0, 1); PG8_STAGE(PG8_SB(0, 0), b2, voffB); PG8_STAGE(PG8_SB(0, 1), b2 + hstepB, voffB); PG8_STAGE(PG8_SA(0, 0), a2, voffA);
            PG8_WAIT_V(8); PG8_WAIT_L(0); PG8_BAR; PG8_MMA(1, 0, At, B0); PG8_MMA(1, 1, At, B1); PG8_BAR; PG8_SCHED;
            PG8_LDB(B0, 1, 0); PG8_LDB(B1, 1, 1); PG8_SCHED; PG8_LDA(At, 1, 0); PG8_STAGE(PG8_SA(0, 1), a2 + hstepA, voffA);
            PG8_WAIT_V(8); PG8_WAIT_L(0); PG8_BAR; PG8_MMA(0, 0, At, B0); PG8_MMA(0, 1, At, B1); PG8_BAR; PG8_SCHED;
            PG8_LDA(At, 1, 1); PG8_STAGE(PG8_SB(1, 0), b3, voffB); PG8_STAGE(PG8_SB(1, 1), b3 + hstepB, voffB); PG8_STAGE(PG8_SA(1, 0), a3, voffA);
            PG8_WAIT_V(8); PG8_WAIT_L(0); PG8_BAR; PG8_MMA(1, 0, At, B0); PG8_MMA(1, 1, At, B1); PG8_BAR; PG8_SCHED;
        }
        if constexpr (ALIGN_EPI) { if (wr == 0) PG8_BAR; }
        { int t2 = threadIdx.x; asm volatile("" : "+v"(t2));
          const int w2 = __builtin_amdgcn_readfirstlane(t2 >> 6), l2 = t2 & 63; E(acc, cur, w2 >> 2, w2 & 3, l2 & 15, l2 >> 4); }
        if (!has_next) break;
#pragma unroll
        for (int a = 0; a < 2; ++a)
#pragma unroll
            for (int b = 0; b < 2; ++b)
#pragma unroll
                for (int m = 0; m < 4; ++m)
#pragma unroll
                    for (int n = 0; n < 2; ++n) acc[a][b][m][n] = (f32x4){0.f, 0.f, 0.f, 0.f};
        cur = nxt; cA = nA; cB = nB; ++ui;
        if constexpr (ALIGN_EPI) { if (wr == 1) PG8_BAR; }
    }
    PG8_WAIT_V(0);
    if constexpr (!ALIGN_EPI) { if (wr == 0) PG8_BAR; }
    PG8_BAR;
#undef PG8_SA
#undef PG8_SB
#undef PG8_STAGE
#undef PG8_LDA
#undef PG8_LDB
#undef PG8_MMA
#undef PG8_WAIT_V
#undef PG8_WAIT_L
#undef PG8_BAR
#undef PG8_SCHED
}
}
using pg8::Unit;

#define EPI_ROWS(ai, m) (u.pm * 256 + (ai) * 128 + wr * 64 + (m) * 16 + fr)
#define EPI_COL(bj) (u.pn * 256 + (bj) * 128 + wc * 32 + 8 * fq)
typedef const f32x4 (&AccRef)[2][2][4][2];

__device__ __forceinline__ void rope8(f32x4& v0, f32x4& v1, const float* ropeRow, int fq) {
    const int i0 = 8 * (fq & 1);
    const f32x4 c0 = *(const f32x4*)(ropeRow + i0), c1 = *(const f32x4*)(ropeRow + i0 + 4), s0 = *(const f32x4*)(ropeRow + 16 + i0), s1 = *(const f32x4*)(ropeRow + 16 + i0 + 4);
    f32x4 o0, o1;
#pragma unroll
    for (int e = 0; e < 4; ++e) { o0[e] = __shfl_xor(v0[e], 32); o1[e] = __shfl_xor(v1[e], 32); }
    if (fq < 2) { v0 = v0 * c0 - o0 * s0; v1 = v1 * c1 - o1 * s1; }
    else        { v0 = v0 * c0 + o0 * s0; v1 = v1 * c1 + o1 * s1; }
}

struct EpiIn {
    bf16_t* PM; float* SSQ; bf16_t* KPE; bf16_t* PR; bf16_t* GS; const float* rope;
    __device__ __forceinline__ void operator()(AccRef acc, const Unit& u, int wr, int wc, int fr, int fq) const {
#pragma unroll
        for (int bj = 0; bj < 2; ++bj) {
            const int cgp = u.pn * 256 + bj * 128 + wc * 32;
            if (cgp >= 672 && cgp < 768) continue;
#pragma unroll
            for (int ai = 0; ai < 2; ++ai)
#pragma unroll
                for (int m = 0; m < 4; ++m) {
                    const int row = EPI_ROWS(ai, m);
                    f32x4 v0 = acc[ai][bj][m][0], v1 = acc[ai][bj][m][1];
                    if (cgp < 640) {
                        *(u32x4*)(PM + (size_t)row * 640 + cgp + 8 * fq) = pack8(v0, v1);
                        float s = (v0[0] * v0[0] + v0[1] * v0[1]) + (v0[2] * v0[2] + v0[3] * v0[3]) + (v1[0] * v1[0] + v1[1] * v1[1]) + (v1[2] * v1[2] + v1[3] * v1[3]);
                        s += __shfl_xor(s, 16); s += __shfl_xor(s, 32);
                        if (fq == 0) SSQ[(size_t)row * 20 + (cgp >> 5)] = s;
                    } else if (cgp == 640) {
                        rope8(v0, v1, rope + pos_of_row(row) * 32, fq);
                        *(u32x4*)(KPE + (size_t)row * 32 + 8 * fq) = pack8(v0, v1);
                    } else if (cgp < 2560) {
                        *(u32x4*)(PR + (size_t)row * 1792 + (cgp - 768) + 8 * fq) = pack8(v0, v1);
                    } else {
#pragma unroll
                        for (int e = 0; e < 4; ++e) { v0[e] = sigmoidf_(v0[e]); v1[e] = sigmoidf_(v1[e]); }
                        *(u32x4*)(GS + (size_t)row * 2048 + (cgp - 2560) + 8 * fq) = pack8(v0, v1);
                    }
                }
        }
    }
};
struct EpiQ {
    const float* SSQ; bf16_t* Q;
    __device__ __forceinline__ void operator()(AccRef acc, const Unit& u, int wr, int wc, int fr, int fq) const {
#pragma unroll
        for (int ai = 0; ai < 2; ++ai)
#pragma unroll
            for (int m = 0; m < 4; ++m) {
                const int row = EPI_ROWS(ai, m);
                const float* sp = SSQ + (size_t)row * 20; float s = 0.f;
#pragma unroll
                for (int g4 = 0; g4 < 3; ++g4) { const f32x4 t = *(const f32x4*)(sp + 4 * g4); s += (t[0] + t[1]) + (t[2] + t[3]); asm volatile("" : "+v"(s) :: "memory"); }
                const float sc = rsqrtf(s * (1.0f / 384.0f) + EPS) * QSCALE;
#pragma unroll
                for (int bj = 0; bj < 2; ++bj) {
                    f32x4 v0 = acc[ai][bj][m][0] * sc, v1 = acc[ai][bj][m][1] * sc;
                    *(u32x4*)(Q + (size_t)row * 768 + EPI_COL(bj)) = pack8(v0, v1);
                }
            }
    }
};
struct EpiK {
    const float* SSQ; bf16_t* KN;
    __device__ __forceinline__ void operator()(AccRef acc, const Unit& u, int wr, int wc, int fr, int fq) const {
#pragma unroll
        for (int ai = 0; ai < 2; ++ai)
#pragma unroll
            for (int m = 0; m < 4; ++m) {
                const int row = EPI_ROWS(ai, m);
                const float* sp = SSQ + (size_t)row * 20 + 12; float s = 0.f;
#pragma unroll
                for (int g4 = 0; g4 < 2; ++g4) { const f32x4 t = *(const f32x4*)(sp + 4 * g4); s += (t[0] + t[1]) + (t[2] + t[3]); }
                const float sc = rsqrtf(s * (1.0f / 256.0f) + EPS);
#pragma unroll
                for (int bj = 0; bj < 2; ++bj)
                    *(u32x4*)(KN + (size_t)row * 512 + EPI_COL(bj)) = pack8(acc[ai][bj][m][0] * sc, acc[ai][bj][m][1] * sc);
            }
    }
};
struct EpiVT {
    const float* SSQ; bf16_t* VT;
    __device__ __forceinline__ void operator()(AccRef acc, const Unit& u, int wr, int wc, int fr, int fq) const {
#pragma unroll
        for (int bj = 0; bj < 2; ++bj) {
            const int tok0 = EPI_COL(bj);
            f32x4 sc0, sc1;
#pragma unroll
            for (int e = 0; e < 8; ++e) {
                const float* sp = SSQ + (size_t)(tok0 + e) * 20 + 12;
                const f32x4 t0 = *(const f32x4*)sp, t1 = *(const f32x4*)(sp + 4);
                const float s = ((t0[0] + t0[1]) + (t0[2] + t0[3])) + ((t1[0] + t1[1]) + (t1[2] + t1[3]));
                const float sc = rsqrtf(s * (1.0f / 256.0f) + EPS);
                if (e < 4) sc0[e] = sc; else sc1[e - 4] = sc;
            }
#pragma unroll
            for (int ai = 0; ai < 2; ++ai)
#pragma unroll
                for (int m = 0; m < 4; ++m) {
                    const int row = EPI_ROWS(ai, m);
                    *(u32x4*)(VT + (size_t)row * MT + tok0) = pack8(acc[ai][bj][m][0] * sc0, acc[ai][bj][m][1] * sc1);
                }
        }
    }
};
struct EpiG {
    bf16_t* G;
    __device__ __forceinline__ void operator()(AccRef acc, const Unit& u, int wr, int wc, int fr, int fq) const {
#pragma unroll
        for (int ai = 0; ai < 2; ++ai)
#pragma unroll
            for (int m = 0; m < 4; ++m) { const int row = EPI_ROWS(ai, m);
#pragma unroll
                for (int bj = 0; bj < 2; ++bj) *(u32x4*)(G + (size_t)row * 512 + EPI_COL(bj)) = pack8(acc[ai][bj][m][0], acc[ai][bj][m][1]); }
    }
};
struct EpiMo {
    const bf16_t* GS; bf16_t* T1A; bf16_t* T1B;
    __device__ __forceinline__ void operator()(AccRef acc, const Unit& u, int wr, int wc, int fr, int fq) const {
#pragma unroll
        for (int ai = 0; ai < 2; ++ai)
#pragma unroll
            for (int m = 0; m < 4; ++m) { const int row = EPI_ROWS(ai, m);
#pragma unroll
                for (int bj = 0; bj < 2; ++bj) { const int col = EPI_COL(bj);
                    f32x4 g0, g1; unpack8(*(const u32x4*)(GS + (size_t)row * 2048 + col), g0, g1);
                    bf16_t* T1 = row < MT / 2 ? T1A : T1B - (size_t)(MT / 2) * 1024;
                    *(u32x4*)(T1 + (size_t)row * 1024 + col) = pack8(acc[ai][bj][m][0] * g0, acc[ai][bj][m][1] * g1); } }
    }
};
struct EpiRo {
    const bf16_t* GS; const bf16_t* T1A; const bf16_t* T1B; bf16_t* MIX;
    __device__ __forceinline__ void operator()(AccRef acc, const Unit& u, int wr, int wc, int fr, int fq) const {
#pragma unroll
        for (int ai = 0; ai < 2; ++ai)
#pragma unroll
            for (int m = 0; m < 4; ++m) { const int row = EPI_ROWS(ai, m);
#pragma unroll
                for (int bj = 0; bj < 2; ++bj) { const int col = EPI_COL(bj);
                    const bf16_t* T1 = row < MT / 2 ? T1A : T1B - (size_t)(MT / 2) * 1024;
                    f32x4 g0, g1, t0, t1; unpack8(*(const u32x4*)(GS + (size_t)row * 2048 + 1024 + col), g0, g1); unpack8(*(const u32x4*)(T1 + (size_t)row * 1024 + col), t0, t1);
                    *(u32x4*)(MIX + (size_t)row * 1024 + col) = pack8(t0 + acc[ai][bj][m][0] * g0, t1 + acc[ai][bj][m][1] * g1); } }
    }
};
struct EpiRes {
    const float* baseP; const float* baseS; float* out; const float* gate;
    __device__ __forceinline__ void operator()(AccRef acc, const Unit& u, int wr, int wc, int fr, int fq) const {
        const int r0 = u.pm * 256; const int sq = seq_of_row(r0);
        const float* base = r0 < MP ? baseP : baseS - (size_t)MP * 1024;
#pragma unroll
        for (int bj = 0; bj < 2; ++bj) { const int col = EPI_COL(bj);
            const f32x4 g0 = *(const f32x4*)(gate + sq * 6144 + col), g1 = *(const f32x4*)(gate + sq * 6144 + col + 4);
#pragma unroll
            for (int ai = 0; ai < 2; ++ai)
#pragma unroll
                for (int m = 0; m < 4; ++m) { const int row = EPI_ROWS(ai, m);
                    const float* bp = base + (size_t)row * 1024 + col; float* op = out + (size_t)row * 1024 + col;
                    const f32x4 a = *(const f32x4*)bp + acc[ai][bj][m][0] * g0, b = *(const f32x4*)(bp + 4) + acc[ai][bj][m][1] * g1;
                    *(f32x4*)op = a; *(f32x4*)(op + 4) = b; } }
    }
};
struct EpiRes2 {
    const float* baseP; const float* baseS; float* out; const float* mod; const float* gn2; bf16_t* A2; float* SSQ2;
    __device__ __forceinline__ void operator()(AccRef acc, const Unit& u, int wr, int wc, int fr, int fq) const {
        const int r0 = u.pm * 256; const int sq = seq_of_row(r0);
        const float* base = r0 < MP ? baseP : baseS - (size_t)MP * 1024;
        float ss[2][4];
#pragma unroll
        for (int ai = 0; ai < 2; ++ai)
#pragma unroll
            for (int m = 0; m < 4; ++m) ss[ai][m] = 0.f;
#pragma unroll
        for (int bj = 0; bj < 2; ++bj) { const int col = EPI_COL(bj);
            const f32x4 g0 = *(const f32x4*)(mod + sq * 6144 + 2048 + col), g1 = *(const f32x4*)(mod + sq * 6144 + 2048 + col + 4);
            const f32x4 s0 = *(const f32x4*)(gn2 + col) * (*(const f32x4*)(mod + sq * 6144 + 4096 + col) + 1.0f), s1 = *(const f32x4*)(gn2 + col + 4) * (*(const f32x4*)(mod + sq * 6144 + 4096 + col + 4) + 1.0f);
#pragma unroll
            for (int ai = 0; ai < 2; ++ai)
#pragma unroll
                for (int m = 0; m < 4; ++m) { const int row = EPI_ROWS(ai, m);
                    const float* bp = base + (size_t)row * 1024 + col; float* op = out + (size_t)row * 1024 + col;
                    const f32x4 a = *(const f32x4*)bp + acc[ai][bj][m][0] * g0, b = *(const f32x4*)(bp + 4) + acc[ai][bj][m][1] * g1;
                    *(f32x4*)op = a; *(f32x4*)(op + 4) = b;
                    *(u32x4*)(A2 + (size_t)row * 1024 + col) = pack8(a * s0, b * s1);
                    ss[ai][m] += (a[0] * a[0] + a[1] * a[1]) + (a[2] * a[2] + a[3] * a[3]) + (b[0] * b[0] + b[1] * b[1]) + (b[2] * b[2] + b[3] * b[3]); } }
#pragma unroll
        for (int ai = 0; ai < 2; ++ai)
#pragma unroll
            for (int m = 0; m < 4; ++m) { const float v = sum_rows4(ss[ai][m]);
                if (fq == 0) atomicAdd(SSQ2 + EPI_ROWS(ai, m), v); }
    }
};
struct EpiFfn {
    bf16_t* H; const float* SSQ2; const float* C2;
    __device__ __forceinline__ void operator()(AccRef acc, const Unit& u, int wr, int wc, int fr, int fq) const {
        const int sq = seq_of_row(u.pm * 256); const float* cp = C2 + (size_t)sq * 5632 + u.pn * 256 + wc * 32 + 8 * fq;
        const f32x4 cu0 = *(const f32x4*)cp, cu1 = *(const f32x4*)(cp + 4), cz0 = *(const f32x4*)(cp + 128), cz1 = *(const f32x4*)(cp + 132);
#pragma unroll
        for (int ai = 0; ai < 2; ++ai)
#pragma unroll
            for (int m = 0; m < 4; ++m) { const int row = EPI_ROWS(ai, m);
                const float rstd = rsqrtf(SSQ2[row] * (1.0f / DM) + EPS);
                f32x4 a, b;
#pragma unroll
                for (int e = 0; e < 4; ++e) { const float u0 = acc[ai][0][m][0][e] * rstd + cu0[e], u1 = acc[ai][0][m][1][e] * rstd + cu1[e];
                    a[e] = u0 * sigmoidf_(u0) * (acc[ai][1][m][0][e] * rstd + cz0[e]); b[e] = u1 * sigmoidf_(u1) * (acc[ai][1][m][1][e] * rstd + cz1[e]); }
                *(u32x4*)(H + (size_t)row * DFF + u.pn * 128 + wc * 32 + 8 * fq) = pack8(a, b); }
    }
};

template <class F>
__device__ __forceinline__ void transpose_items(const float* W, int ldw, int K, int Ndst, bf16_t* WT, F srcmap, const float* gain, LAS float* scr, int gw, int ngw, int lane) {
    const int nblk = Ndst / 32, nitems = (K / 64) * nblk;
    for (int item = gw; item < nitems; item += ngw) {
        const int kb = item / nblk, nb = item % nblk, k0 = 64 * kb, n0 = 32 * nb; const int sc = srcmap(n0);
#pragma unroll 8
        for (int i = 0; i < 32; ++i) { const int kk = 2 * i + (lane >> 5);
            float v = 0.f; if (sc >= 0) { v = W[(size_t)(k0 + kk) * ldw + sc + (lane & 31)]; if (gain) v *= gain[k0 + kk]; }
            scr[kk * 33 + (lane & 31)] = v; }
        asm volatile("s_waitcnt lgkmcnt(0)" ::: "memory");
        const int c = lane & 7;
#pragma unroll
        for (int j = 0; j < 4; ++j) { const int n = (lane >> 3) + 8 * j; const LAS float* s = scr + (8 * c) * 33 + n;
            u32x4 o; o.x = cvtpk(s[0 * 33], s[1 * 33]); o.y = cvtpk(s[2 * 33], s[3 * 33]); o.z = cvtpk(s[4 * 33], s[5 * 33]); o.w = cvtpk(s[6 * 33], s[7 * 33]);
            *(u32x4*)(WT + (size_t)(n0 + n) * K + k0 + 8 * c) = o; }
        asm volatile("s_waitcnt lgkmcnt(0)" ::: "memory");
    }
}

struct Args {
    const float* in[30]; float* out; unsigned char* ws;
};

__device__ __forceinline__ void adaln_row(const float* xrow, const float* gn, const float* sc, const float* sh, bf16_t* orow, int lane) {
    f32x4 v[4]; float s = 0.f;
#pragma unroll
    for (int j = 0; j < 4; ++j) { v[j] = *(const f32x4*)(xrow + 4 * lane + 256 * j); s += (v[j][0] * v[j][0] + v[j][1] * v[j][1]) + (v[j][2] * v[j][2] + v[j][3] * v[j][3]); }
    const float rstd = rsqrtf(sum64q(s) * (1.0f / DM) + EPS);
#pragma unroll
    for (int j = 0; j < 4; ++j) { const int c = 4 * lane + 256 * j;
        const f32x4 g = *(const f32x4*)(gn + c), s1 = *(const f32x4*)(sc + c), h1 = *(const f32x4*)(sh + c);
        const f32x4 o = v[j] * rstd * g * (s1 + 1.0f) + h1;
        u32x2 w; w.x = cvtpk(o[0], o[1]); w.y = cvtpk(o[2], o[3]); *(u32x2*)(orow + c) = w; }
}

constexpr int KP = 104, VP = 72;
constexpr int ATT_K_BYTES = 64 * KP * 2, ATT_V_BYTES = 64 * VP * 2;
__device__ __forceinline__ int crow(int r, int hi) { return (r & 3) + 8 * (r >> 2) + 4 * hi; }
__device__ __forceinline__ void attn_unit(int row0, int T, int h, int qb, const bf16_t* Q, const bf16_t* KN, const bf16_t* KPE, const bf16_t* VT, bf16_t* O, const float* rope, LAS unsigned char* lds) {
    int tid = threadIdx.x; asm volatile("" : "+v"(tid));
    const int lane = tid & 63, wid = __builtin_amdgcn_readfirstlane(tid >> 6), r32 = lane & 31, hi = lane >> 5;
    LAS unsigned char* Kl = lds; LAS unsigned char* Vl = lds + 3 * ATT_K_BYTES; LAS float* wsf = (LAS float*)(lds + 3 * ATT_K_BYTES + 2 * ATT_V_BYTES) + wid * 32;
    const int qrow = row0 + qb * 256 + wid * 32;
    bf16x8 qf[6];
    { const bf16_t* qp = Q + (size_t)(qrow + r32) * 768;
#pragma unroll
      for (int d0 = 0; d0 < 4; ++d0) qf[d0] = *(const bf16x8*)(qp + h * 64 + 16 * d0 + 8 * hi);
#pragma unroll
      for (int d0 = 0; d0 < 2; ++d0) qf[4 + d0] = *(const bf16x8*)(qp + 512 + h * 32 + 16 * d0 + 8 * hi);
      const float* rp = rope + (qb * 256 + wid * 32 + r32) * 32 + 8 * hi;
      f32x4 x1a, x1b, x2a, x2b; unpack8(__builtin_bit_cast(u32x4, qf[4]), x1a, x1b); unpack8(__builtin_bit_cast(u32x4, qf[5]), x2a, x2b);
      const f32x4 ca = *(const f32x4*)rp, cb = *(const f32x4*)(rp + 4), sa = *(const f32x4*)(rp + 16), sb = *(const f32x4*)(rp + 20);
      qf[4] = __builtin_bit_cast(bf16x8, pack8(x1a * ca - x2a * sa, x1b * cb - x2b * sb));
      qf[5] = __builtin_bit_cast(bf16x8, pack8(x2a * ca + x1a * sa, x2b * cb + x1b * sb)); }
    f32x16 o0, o1, negm;
#pragma unroll
    for (int r = 0; r < 16; ++r) { o0[r] = 0.f; o1[r] = 0.f; negm[r] = 0.f; }
    float mhat = 0.f, lrun = 0.f;
    const int ntiles = T / 64;
    typedef __attribute__((address_space(1))) const u32x4 gv4;
    const int kr = tid >> 3, kc = tid & 7;
    const int pr = (tid & 255) >> 2, pc = tid & 3;
    const bf16_t* gk = KN + (size_t)(row0 + kr) * 512 + h * 64 + 8 * kc;
    const bf16_t* gp = KPE + (size_t)(row0 + pr) * 32 + 8 * pc;
    const bf16_t* gv = VT + (size_t)(h * 64 + kr) * MT + row0 + 8 * kc;
    const int lk = (kr * KP + 8 * kc) * 2, lp = (pr * KP + 64 + 8 * pc) * 2, lv = (kr * VP + 8 * kc) * 2;
    const int fi = (r32 & 0x13) | ((r32 & 4) << 1) | ((r32 & 8) >> 1);
    const int koff = (fi * KP + 8 * hi) * 2, voff = (r32 * VP + 8 * hi) * 2;
    u32x4 sk, sp, sv;
    sk = *(gv4*)gk; sv = *(gv4*)gv; if (tid < 256) sp = *(gv4*)gp;
    *(LAS u32x4*)(Kl + lk) = sk; *(LAS u32x4*)(Vl + lv) = sv; if (tid < 256) *(LAS u32x4*)(Kl + lp) = sp;
    sk = *(gv4*)(gk + (size_t)64 * 512); if (tid < 256) sp = *(gv4*)(gp + (size_t)64 * 32);
    *(LAS u32x4*)(Kl + ATT_K_BYTES + lk) = sk; if (tid < 256) *(LAS u32x4*)(Kl + ATT_K_BYTES + lp) = sp;
    __syncthreads();
#define ATT_QK(P0, P1, KB) do { _Pragma("unroll") for (int d0 = 0; d0 < 6; ++d0) { \
        const bf16x8 k0_ = *(const LAS bf16x8*)((KB) + d0 * 32), k1_ = *(const LAS bf16x8*)((KB) + 32 * KP * 2 + d0 * 32); \
        if (d0 == 0) { P0 = __builtin_amdgcn_mfma_f32_32x32x16_bf16(k0_, qf[0], negm, 0, 0, 0); P1 = __builtin_amdgcn_mfma_f32_32x32x16_bf16(k1_, qf[0], negm, 0, 0, 0); } \
        else { P0 = __builtin_amdgcn_mfma_f32_32x32x16_bf16(k0_, qf[d0], P0, 0, 0, 0); P1 = __builtin_amdgcn_mfma_f32_32x32x16_bf16(k1_, qf[d0], P1, 0, 0, 0); } } } while (0)
    const bool ahead = ((wid ^ (wid >> 2)) & 1) != 0;
    f32x16 p0, p1, n0, n1;
    if (ahead) ATT_QK(p0, p1, Kl + koff);
    int kcur = 0, knxt = 1, knn = 2;
    for (int t = 0; t < ntiles; ++t) {
        const bool has1 = (t + 1 < ntiles), has2 = (t + 2 < ntiles);
        if (has2) { sk = *(gv4*)(gk + (size_t)(t + 2) * 64 * 512); if (tid < 256) sp = *(gv4*)(gp + (size_t)(t + 2) * 64 * 32); }
        if (has1) sv = *(gv4*)(gv + (t + 1) * 64);
        if (!ahead) { __builtin_amdgcn_s_setprio(1); ATT_QK(p0, p1, Kl + kcur * ATT_K_BYTES + koff); __builtin_amdgcn_s_setprio(0); }
        const LAS unsigned char* vb = Vl + (t & 1) * ATT_V_BYTES + voff;
        asm volatile("s_nop 15\n\ts_nop 7" : "+v"(p0), "+v"(p1));
        float rm;
        { float a = max3f(p0[0], p0[1], p1[0]), b = max3f(p0[2], p0[3], p1[1]); a = max3f(a, p1[2], p1[3]);
#pragma unroll
          for (int r = 4; r < 16; r += 4) { a = max3f(a, p0[r], p0[r + 1]); b = max3f(b, p0[r + 2], p0[r + 3]); a = max3f(a, p1[r], p1[r + 1]); b = max3f(b, p1[r + 2], p1[r + 3]); }
          rm = max3f(a, b, b);
          auto rr = __builtin_amdgcn_permlane32_swap(__float_as_uint(rm), __float_as_uint(rm), false, false);
          rm = max3f(__uint_as_float(rr[0]), __uint_as_float(rr[1]), rm); }
        const bool first = (t == 0);
        if (first || __any(rm > 8.0f)) {
            const float dl = first ? rm : fmaxf(rm, 0.f);
            mhat += dl;
#pragma unroll
            for (int r = 0; r < 16; ++r) { p0[r] -= dl; p1[r] -= dl; negm[r] = -mhat; }
            if (!first) {
                const float f = __builtin_amdgcn_exp2f(-dl); lrun *= f;
                if (hi == 0) wsf[r32] = f;
                asm volatile("s_waitcnt lgkmcnt(0)" ::: "memory");
#pragma unroll
                for (int r = 0; r < 16; ++r) { const float ff = wsf[crow(r, hi)]; o0[r] *= ff; o1[r] *= ff; }
            }
        }
        f32x2 ls2 = {0.f, 0.f};
#pragma unroll
        for (int r = 0; r < 16; r += 2) { p0[r] = __builtin_amdgcn_exp2f(p0[r]); p0[r + 1] = __builtin_amdgcn_exp2f(p0[r + 1]); p1[r] = __builtin_amdgcn_exp2f(p1[r]); p1[r + 1] = __builtin_amdgcn_exp2f(p1[r + 1]);
            ls2 += (f32x2){p0[r], p0[r + 1]}; ls2 += (f32x2){p1[r], p1[r + 1]}; }
        lrun += ls2[0] + ls2[1];
        __builtin_amdgcn_s_setprio(1);
        if (ahead && has1) ATT_QK(n0, n1, Kl + knxt * ATT_K_BYTES + koff);
        u32x4 pw[4];
        pw[0] = (u32x4){cvtpk(p0[0], p0[1]), cvtpk(p0[2], p0[3]), cvtpk(p0[4], p0[5]), cvtpk(p0[6], p0[7])};
        pw[1] = (u32x4){cvtpk(p0[8], p0[9]), cvtpk(p0[10], p0[11]), cvtpk(p0[12], p0[13]), cvtpk(p0[14], p0[15])};
        pw[2] = (u32x4){cvtpk(p1[0], p1[1]), cvtpk(p1[2], p1[3]), cvtpk(p1[4], p1[5]), cvtpk(p1[6], p1[7])};
        pw[3] = (u32x4){cvtpk(p1[8], p1[9]), cvtpk(p1[10], p1[11]), cvtpk(p1[12], p1[13]), cvtpk(p1[14], p1[15])};
#pragma unroll
        for (int j = 0; j < 4; ++j) {
            const bf16x8 v0 = *(const LAS bf16x8*)(vb + j * 32), v1 = *(const LAS bf16x8*)(vb + 32 * VP * 2 + j * 32);
            const bf16x8 pa = __builtin_bit_cast(bf16x8, pw[j]);
            o0 = __builtin_amdgcn_mfma_f32_32x32x16_bf16(pa, v0, o0, 0, 0, 0);
            o1 = __builtin_amdgcn_mfma_f32_32x32x16_bf16(pa, v1, o1, 0, 0, 0);
        }
        __builtin_amdgcn_s_setprio(0);
        if (has2) { *(LAS u32x4*)(Kl + knn * ATT_K_BYTES + lk) = sk; if (tid < 256) *(LAS u32x4*)(Kl + knn * ATT_K_BYTES + lp) = sp; }
        if (has1) *(LAS u32x4*)(Vl + ((t + 1) & 1) * ATT_V_BYTES + lv) = sv;
        __syncthreads();
        if (ahead) { p0 = n0; p1 = n1; }
        { const int tmp = kcur; kcur = knxt; knxt = knn; knn = tmp; }
    }
#undef ATT_QK
    { auto rr = __builtin_amdgcn_permlane32_swap(__float_as_uint(lrun), __float_as_uint(lrun), false, false); lrun = __uint_as_float(rr[0]) + __uint_as_float(rr[1]); }
    if (hi == 0) wsf[r32] = 1.0f / lrun;
    asm volatile("s_waitcnt lgkmcnt(0)" ::: "memory");
#pragma unroll
    for (int r = 0; r < 16; ++r) { const int q = crow(r, hi); const float f = wsf[q];
        bf16_t* op = O + (size_t)(qrow + q) * 512 + h * 64 + r32;
        op[0] = (bf16_t)(cvtpk(o0[r] * f, 0.f) & 0xffffu); op[32] = (bf16_t)(cvtpk(o1[r] * f, 0.f) & 0xffffu); }
    __syncthreads();
}

constexpr int SC_CH = 16;
constexpr int SC_BUF_FLOATS = 6 * SC_CH * 64;
constexpr int SC_YSTEP = 8 * 8 * 2 + 4;
typedef __attribute__((address_space(1))) const u32x4 g_u32x4;
typedef __attribute__((address_space(1))) const f32x4 g_f32x4;
typedef __attribute__((address_space(1))) const bf16_t g_bf16;
struct ScanW { const float *mu, *w0, *wd, *a0, *wa, *kk_, *ka, *rk; };
__device__ __forceinline__ float sum16(float x) { x += dpp_f<0xB1>(x); x += dpp_f<0x4E>(x); x += dpp_f<0x141>(x); x += dpp_f<0x140>(x); return x; }
__device__ __forceinline__ float sum64(float x) { return sum_rows4(sum16(x)); }
__device__ __forceinline__ float mixv(float pm, float p0, float pp, float mu) { return p0 + mu * (0.5f * (pm + pp) - p0); }
#define SC_BAR() do { asm volatile("s_waitcnt lgkmcnt(0)" ::: "memory"); __builtin_amdgcn_s_barrier(); asm volatile("" ::: "memory"); } while (0)
__device__ __forceinline__ void scan_chain(int row0, int T, int h, int dir, const bf16_t* PR, const bf16_t* TA, const ScanW W, bf16_t* Y, float* BON, LAS float* sl) {
    int tid = threadIdx.x; asm volatile("" : "+v"(tid));
    const int lane = tid & 63, wid = __builtin_amdgcn_readfirstlane(tid >> 6);
    const int nchunks = T / SC_CH;
    if (wid >= 4) {
        const int pw = wid - 4, n = lane & 15, q = lane >> 4;
        bf16x8 bd[4][2], ba[4][2];
#pragma unroll
        for (int cb = 0; cb < 4; ++cb)
#pragma unroll
            for (int kh = 0; kh < 2; ++kh) {
                unsigned tw_[4], ta_[4];
#pragma unroll
                for (int i2 = 0; i2 < 4; ++i2) { const int k = 32 * kh + 8 * q + 2 * i2; const int col = h * 64 + 4 * n + cb;
                    tw_[i2] = cvtpk(W.wd[(size_t)(dir * 64 + k) * 512 + col], W.wd[(size_t)(dir * 64 + k + 1) * 512 + col]);
                    ta_[i2] = cvtpk(W.wa[(size_t)(dir * 64 + k) * 512 + col], W.wa[(size_t)(dir * 64 + k + 1) * 512 + col]); }
                bd[cb][kh] = __builtin_bit_cast(bf16x8, (u32x4){tw_[0], tw_[1], tw_[2], tw_[3]}); ba[cb][kh] = __builtin_bit_cast(bf16x8, (u32x4){ta_[0], ta_[1], ta_[2], ta_[3]});
            }
        const int gcol = h * 64 + 4 * n;
        typedef __attribute__((address_space(1))) const u32x2 g_u32x2;
        const f32x4 c_w0 = *(g_f32x4*)(W.w0 + dir * 512 + gcol), c_a0 = *(g_f32x4*)(W.a0 + dir * 512 + gcol), c_kk = *(g_f32x4*)(W.kk_ + gcol), c_ka = *(g_f32x4*)(W.ka + gcol), c_rk = *(g_f32x4*)(W.rk + gcol);
        const f32x4 mu_r = *(g_f32x4*)(W.mu + gcol), mu_k = *(g_f32x4*)(W.mu + 512 + gcol), mu_v = *(g_f32x4*)(W.mu + 1024 + gcol);
        for (int i = 0; i < pw; ++i) SC_BAR();
        for (int c = pw; c < nchunks; c += 4) {
            const int sA = c * SC_CH + n; const int tA = dir ? (T - 1 - sA) : sA;
            const bf16_t* tp = TA + (size_t)(row0 + tA) * 128 + 8 * q;
            const u32x4 ra0 = *(g_u32x4*)tp, ra1 = *(g_u32x4*)(tp + 32), ra2 = *(g_u32x4*)(tp + 64), ra3 = *(g_u32x4*)(tp + 96);
            const int s0 = c * SC_CH + 4 * q;
            const int tlo = dir ? (T - 1 - (s0 + 3)) : s0;
            u32x2 ra_[6], rb_[6], rc_[6];
#pragma unroll
            for (int jr = 0; jr < 6; ++jr) { const int tt = tlo - 1 + jr; const bool ok = (tt >= 0) && (tt < T);
                const bf16_t* pp = PR + (size_t)(row0 + (ok ? tt : 0)) * 1792 + gcol; const u32x2 z2 = {0u, 0u};
                ra_[jr] = ok ? *(g_u32x2*)pp : z2; rb_[jr] = ok ? *(g_u32x2*)(pp + 512) : z2; rc_[jr] = ok ? *(g_u32x2*)(pp + 1024) : z2; }
            SC_BAR();
            f32x4 dw[4], da[4];
#pragma unroll
            for (int cb = 0; cb < 4; ++cb) {
                f32x4 xw = {0.f, 0.f, 0.f, 0.f}, xa = {0.f, 0.f, 0.f, 0.f};
                xw = __builtin_amdgcn_mfma_f32_16x16x32_bf16(__builtin_bit_cast(bf16x8, ra0), bd[cb][0], xw, 0, 0, 0); xw = __builtin_amdgcn_mfma_f32_16x16x32_bf16(__builtin_bit_cast(bf16x8, ra1), bd[cb][1], xw, 0, 0, 0);
                xa = __builtin_amdgcn_mfma_f32_16x16x32_bf16(__builtin_bit_cast(bf16x8, ra2), ba[cb][0], xa, 0, 0, 0); xa = __builtin_amdgcn_mfma_f32_16x16x32_bf16(__builtin_bit_cast(bf16x8, ra3), ba[cb][1], xa, 0, 0, 0);
                dw[cb] = xw; da[cb] = xa;
            }
            SC_BAR();
            LAS float* B = sl + (c % 3) * SC_BUF_FLOATS;
#define UP4(w) ((f32x4){bflo((w).x), bfhi((w).x), bflo((w).y), bfhi((w).y)})
#pragma unroll
            for (int i = 0; i < 4; ++i) {
                u32x2 am, a0_, ap_, bm, b0_, bp_, cm, c0_, cp_;
                if (dir) { am = ra_[3 - i]; a0_ = ra_[4 - i]; ap_ = ra_[5 - i]; bm = rb_[3 - i]; b0_ = rb_[4 - i]; bp_ = rb_[5 - i]; cm = rc_[3 - i]; c0_ = rc_[4 - i]; cp_ = rc_[5 - i]; }
                else     { am = ra_[i]; a0_ = ra_[1 + i]; ap_ = ra_[2 + i]; bm = rb_[i]; b0_ = rb_[1 + i]; bp_ = rb_[2 + i]; cm = rc_[i]; c0_ = rc_[1 + i]; cp_ = rc_[2 + i]; }
                const int ti = dir ? (tlo + 3 - i) : (tlo + i);
                const f32x4 r = UP4(a0_) + mu_r * ((UP4(am) + UP4(ap_)) * 0.5f - UP4(a0_));
                const f32x4 kr = UP4(b0_) + mu_k * ((UP4(bm) + UP4(bp_)) * 0.5f - UP4(b0_));
                const f32x4 vv = UP4(c0_) + mu_v * ((UP4(cm) + UP4(cp_)) * 0.5f - UP4(c0_));
                f32x4 wdec, av, kkr, kd;
                float ss = 0.f, bon = 0.f;
#pragma unroll
                for (int cb = 0; cb < 4; ++cb) {
                    const float e = 0.60653065971263342f * sigmoidf_(c_w0[cb] + dw[cb][i]); wdec[cb] = __expf(-e);
                    av[cb] = sigmoidf_(c_a0[cb] + da[cb][i]);
                    kkr[cb] = kr[cb] * c_kk[cb]; ss += kkr[cb] * kkr[cb];
                    kd[cb] = kr[cb] * (1.0f + (av[cb] - 1.0f) * c_ka[cb]);
                    bon += r[cb] * kd[cb] * c_rk[cb];
                }
                ss = sum16(ss); bon = sum16(bon);
                const f32x4 kk = kkr * rsqrtf(ss + 1e-12f);
                const int st = 4 * q + i;
                *(LAS f32x4*)(B + (0 * SC_CH + st) * 64 + 4 * n) = wdec; *(LAS f32x4*)(B + (1 * SC_CH + st) * 64 + 4 * n) = kk * av; *(LAS f32x4*)(B + (2 * SC_CH + st) * 64 + 4 * n) = kd;
                *(LAS f32x4*)(B + (3 * SC_CH + st) * 64 + 4 * n) = kk;   *(LAS f32x4*)(B + (4 * SC_CH + st) * 64 + 4 * n) = r;       *(LAS f32x4*)(B + (5 * SC_CH + st) * 64 + 4 * n) = vv;
                if (n == 0) BON[((size_t)dir * MT + row0 + ti) * 8 + h] = bon;
                if (i == 1 || i == 3) SC_BAR();
            }
#undef UP4
        }
        for (int i = 0; i < 4 - pw; ++i) SC_BAR();
    } else {
        const int g = lane >> 3, j = lane & 7, v0 = 16 * wid + 2 * g;
        LAS float* ypart = sl + 3 * SC_BUF_FLOATS + wid * (SC_CH * SC_YSTEP);
        f32x2 S0[4], S1[4];
#pragma unroll
        for (int i = 0; i < 4; ++i) { S0[i] = (f32x2){0.f, 0.f}; S1[i] = (f32x2){0.f, 0.f}; }
        SC_BAR(); SC_BAR(); SC_BAR(); SC_BAR();
        for (int c = 0; c < nchunks; ++c) {
            const LAS float* B = sl + (c % 3) * SC_BUF_FLOATS;
            f32x4 Aw0, Aw1, Ab0, Ab1, Ad0, Ad1, Ak0, Ak1, Ar0, Ar1, Bw0, Bw1, Bb0, Bb1, Bd0, Bd1, Bk0, Bk1, Br0, Br1; f32x2 Av, Bv;
#define SC_LD(X, Bp) do { const LAS f32x4* p_ = (const LAS f32x4*)((Bp) + 8 * j); X##w0 = p_[0]; X##w1 = p_[1]; X##b0 = p_[256]; X##b1 = p_[257]; X##d0 = p_[512]; X##d1 = p_[513]; X##k0 = p_[768]; X##k1 = p_[769]; X##r0 = p_[1024]; X##r1 = p_[1025]; \
                X##v = *(const LAS f32x2*)((Bp) + 5 * 1024 + v0); } while (0)
#define SC_STEP(X, st_) do { \
                const f32x2 w_[4] = {{X##w0[0], X##w0[1]}, {X##w0[2], X##w0[3]}, {X##w1[0], X##w1[1]}, {X##w1[2], X##w1[3]}}, b_[4] = {{X##b0[0], X##b0[1]}, {X##b0[2], X##b0[3]}, {X##b1[0], X##b1[1]}, {X##b1[2], X##b1[3]}}, \
                            kd_[4] = {{X##d0[0], X##d0[1]}, {X##d0[2], X##d0[3]}, {X##d1[0], X##d1[1]}, {X##d1[2], X##d1[3]}}, kk_[4] = {{X##k0[0], X##k0[1]}, {X##k0[2], X##k0[3]}, {X##k1[0], X##k1[1]}, {X##k1[2], X##k1[3]}}, \
                            r_[4] = {{X##r0[0], X##r0[1]}, {X##r0[2], X##r0[3]}, {X##r1[0], X##r1[1]}, {X##r1[2], X##r1[3]}}; \
                const f32x2 vv = X##v; \
                  \
                f32x2 d0 = S0[0] * kk_[0], d1 = S1[0] * kk_[0]; \
                _Pragma("unroll") for (int i = 1; i < 4; ++i) { d0 += S0[i] * kk_[i]; d1 += S1[i] * kk_[i]; } \
                f32x2 t0[4], t1[4]; \
                _Pragma("unroll") for (int i = 0; i < 4; ++i) { t0[i] = S0[i] * w_[i] + kd_[i] * vv[0]; t1[i] = S1[i] * w_[i] + kd_[i] * vv[1]; } \
                const float sa0 = -sum8(d0[0] + d0[1]), sa1 = -sum8(d1[0] + d1[1]); \
                f32x2 y0 = {0.f, 0.f}, y1 = {0.f, 0.f}; \
                _Pragma("unroll") for (int i = 0; i < 4; ++i) { S0[i] = t0[i] + b_[i] * sa0; S1[i] = t1[i] + b_[i] * sa1; y0 += S0[i] * r_[i]; y1 += S1[i] * r_[i]; } \
                *(LAS f32x2*)(ypart + (st_) * SC_YSTEP + (g * 8 + j) * 2) = (f32x2){y0[0] + y0[1], y1[0] + y1[1]}; } while (0)
            SC_LD(A, B);
#pragma unroll
            for (int st = 0; st < SC_CH; st += 2) {
                SC_LD(B, B + (st + 1) * 64);
                SC_STEP(A, st);
                if (st + 2 < SC_CH) SC_LD(A, B + (st + 2) * 64);
                SC_STEP(B, st + 1);
            }
#undef SC_LD
#undef SC_STEP
#pragma unroll
            for (int u = 0; u < 2; ++u) { const int stp = 2 * j + u;
                const LAS f32x4* yp = (const LAS f32x4*)(ypart + stp * SC_YSTEP + g * 16);
                const f32x4 a = (yp[0] + yp[1]) + (yp[2] + yp[3]);
                const float ya = a[0] + a[2], yb = a[1] + a[3];
                const int s = c * SC_CH + stp; const int t = dir ? (T - 1 - s) : s;
                *(__attribute__((address_space(1))) unsigned*)(Y + (size_t)(row0 + t) * 512 + h * 64 + v0) = cvtpk(ya, yb); }
            SC_BAR();
        }
    }
}

#define RLX_AGENT __ATOMIC_RELAXED, __HIP_MEMORY_SCOPE_AGENT
#define XB_TMO      128
#define XB_XCNT(j)  (256  + 64 * (j))
#define XB_XSUB(j)  (1280 + 64 * (j))
#define XB_XGEN(j)  (2304 + 64 * (j))
#define XB_TOP      3328
#define XB_TOPGEN   3392
#define XCD_BAR_WORDS 3456
#define XB_SPIN_CAP (1u << 18)

__device__ __forceinline__ unsigned xb_ld(unsigned* p)              { return __hip_atomic_load(p, __ATOMIC_RELAXED, __HIP_MEMORY_SCOPE_AGENT); }
__device__ __forceinline__ unsigned xb_add(unsigned* p, unsigned v) { return __hip_atomic_fetch_add(p, v, __ATOMIC_RELAXED, __HIP_MEMORY_SCOPE_AGENT); }
__device__ __forceinline__ unsigned xb_xcc_id() { return (unsigned)__builtin_amdgcn_s_getreg((3 << 11) | 20) & 0xFu; }
#define XB_SPIN(cond, bar) do { unsigned _sp = 0; while (cond) { __builtin_amdgcn_s_sleep(1); \
    if ((++_sp & 255u) == 0u) { if (xb_ld(&(bar)[XB_TMO])) break; if (_sp > XB_SPIN_CAP) { atomicAdd(&(bar)[XB_TMO], 1u); break; } } } } while (0)

struct XcdBarrier {
    unsigned* bar; unsigned x;
    volatile LAS unsigned* st;
};

__device__ __forceinline__ XcdBarrier xcd_barrier_post(unsigned* bar, volatile LAS unsigned* st) {
    XcdBarrier b; b.bar = bar; b.x = xb_xcc_id(); b.st = st;
    if (threadIdx.x == 0) (void)xb_add(&bar[XB_XCNT(b.x)], 1u);
    return b;
}
__device__ __forceinline__ void xcd_barrier_complete(unsigned* bar, unsigned x, unsigned& nloc, unsigned& nx) {
    const unsigned G = gridDim.x * gridDim.y * gridDim.z;
    unsigned sum, cnt, mine, sp = 0u;
    for (;;) {
        sum = 0u; cnt = 0u; mine = 0u;
#pragma unroll
        for (unsigned j = 0; j < 16; ++j) { const unsigned c = xb_ld(&bar[XB_XCNT(j)]); sum += c; cnt += (c > 0u) ? 1u : 0u; mine = (j == x) ? c : mine; }
        if (sum == G) break;
        __builtin_amdgcn_s_sleep(1);
        if ((++sp & 255u) == 0u) { if (xb_ld(&bar[XB_TMO])) break; if (sp > XB_SPIN_CAP) { atomicAdd(&bar[XB_TMO], 1u); break; } }
    }
    nloc = mine > 0u ? mine : 1u; nx = cnt > 0u ? cnt : 1u;
}

__device__ __forceinline__ void xcd_barrier(const XcdBarrier& b) {
    asm volatile("s_waitcnt vmcnt(0)" ::: "memory");
    __syncthreads();
    if (threadIdx.x == 0) {
        unsigned* bar = b.bar;
        __builtin_amdgcn_s_waitcnt(0);
        unsigned nloc = b.st[0], nx = b.st[1];
        if (nloc == 0u) { xcd_barrier_complete(bar, b.x, nloc, nx); b.st[0] = nloc; b.st[1] = nx; }
        const unsigned old = xb_add(&bar[XB_XSUB(b.x)], 1u);
        const unsigned gen = old / nloc;
        if (old + 1u == (gen + 1u) * nloc) {
            __builtin_amdgcn_fence(__ATOMIC_RELEASE, "agent");
            asm volatile("s_waitcnt vmcnt(0)" ::: "memory");
            const unsigned og = xb_add(&bar[XB_TOP], 1u);
            const unsigned tg = og / nx;
            if (og + 1u == (tg + 1u) * nx) xb_add(&bar[XB_TOPGEN], 1u);
            else XB_SPIN(xb_ld(&bar[XB_TOPGEN]) == tg, bar);
            __builtin_amdgcn_fence(__ATOMIC_ACQUIRE, "agent");
            xb_add(&bar[XB_XGEN(b.x)], 1u);
            asm volatile("s_waitcnt vmcnt(0)" ::: "memory");
        } else {
            XB_SPIN(xb_ld(&bar[XB_XGEN(b.x)]) == gen, bar);
            __builtin_amdgcn_fence(__ATOMIC_ACQUIRE, "agent");
            asm volatile("s_waitcnt vmcnt(0)" ::: "memory");
        }
    }
    __syncthreads();
}


constexpr int LDS_BYTES = 147456 + 256;
#ifndef REP_ATT
#define REP_ATT 1
#endif
#ifndef REP_SCAN
#define REP_SCAN 1
#endif
#ifndef REP_P2
#define REP_P2 1
#endif
#ifndef REP_FFN
#define REP_FFN 1
#endif
__global__ void __launch_bounds__(512, 2) fwd_kernel(Args a) {
    extern __shared__ __attribute__((aligned(16))) unsigned char lds_raw[];
    LAS unsigned char* lds = (LAS unsigned char*)lds_raw;
    cg::grid_group grid = cg::this_grid();
    const int G = gridDim.x, bx = blockIdx.x;
    const int vcu = (G % 8 == 0) ? (bx % 8) * (G / 8) + bx / 8 : bx;
    if (threadIdx.x < 2) ((volatile LAS unsigned*)(lds + 147456))[threadIdx.x] = 0u;
    __syncthreads();
    if (bx == 0) { unsigned* bw = (unsigned*)(a.ws + WS_BAR); for (int i = threadIdx.x; i < XCD_BAR_WORDS; i += 512) bw[i] = 0u; }
#define PHASE_BEGIN const __attribute__((address_space(4))) Args* ap = (const __attribute__((address_space(4))) Args*)__builtin_amdgcn_kernarg_segment_ptr(); asm volatile("" : "+s"(ap)); int tid = threadIdx.x; asm volatile("" : "+v"(tid)); const int lane = tid & 63, wave = __builtin_amdgcn_readfirstlane(tid >> 6); \
    unsigned char* ws = ap->ws; asm volatile("" : "+s"(ws)); const int gw = vcu * 8 + wave, ngw = G * 8; (void)lane; (void)gw; (void)ngw;
#define WSP(T, off) ((T*)(ws + (off)))

    {
        PHASE_BEGIN
        LAS float* scr = (LAS float*)lds + wave * (64 * 33);
        transpose_items(ap->in[7], 4512, 1024, NPAD_IN, WSP(bf16_t, WS_WIN), [](int n0) { return n0 < 672 ? n0 : (n0 < 768 ? -1 : n0 - 96); }, nullptr, scr, gw, ngw, lane);
        transpose_items(ap->in[10], 768, 384, 768, WSP(bf16_t, WS_WUQ), [](int n0) { return n0 < 512 ? (n0 >> 6) * 96 + (n0 & 63) : ((n0 - 512) >> 5) * 96 + 64; }, ap->in[8], scr, gw, ngw, lane);
        transpose_items(ap->in[11], 1024, 256, 512, WSP(bf16_t, WS_WK), [](int n0) { return (n0 >> 6) * 128 + (n0 & 63); }, ap->in[9], scr, gw, ngw, lane);
        transpose_items(ap->in[11], 1024, 256, 512, WSP(bf16_t, WS_WV), [](int n0) { return (n0 >> 6) * 128 + 64 + (n0 & 63); }, ap->in[9], scr, gw, ngw, lane);
        transpose_items(ap->in[17], 512, 128, 512, WSP(bf16_t, WS_WG), [](int n0) { return n0; }, nullptr, scr, gw, ngw, lane);
        transpose_items(ap->in[23], 1024, 512, 1024, WSP(bf16_t, WS_WMO), [](int n0) { return n0; }, nullptr, scr, gw, ngw, lane);
        transpose_items(ap->in[24], 1024, 512, 1024, WSP(bf16_t, WS_WRO), [](int n0) { return n0; }, nullptr, scr, gw, ngw, lane);
        transpose_items(ap->in[25], 1024, 1024, 1024, WSP(bf16_t, WS_WOUT), [](int n0) { return n0; }, nullptr, scr, gw, ngw, lane);
        transpose_items(ap->in[27], 5632, 1024, 5632, WSP(bf16_t, WS_WFFI), [](int n0) { const int tl = n0 >> 8, wi = n0 & 255; return wi < 128 ? tl * 128 + wi : 2816 + tl * 128 + (wi - 128); }, nullptr, scr, gw, ngw, lane);
        transpose_items(ap->in[28], 1024, 2816, 1024, WSP(bf16_t, WS_WFFO), [](int n0) { return n0; }, nullptr, scr, gw, ngw, lane);
        { float* z2 = WSP(float, WS_SSQ2); for (int i = bx * 512 + tid; i < MT; i += G * 512) z2[i] = 0.f; }
        float* ROPE = WSP(float, WS_ROPE);
        for (int i = bx * 512 + tid; i < TP * 16; i += G * 512) { const int t = i >> 4, f = i & 15;
            const float inv = exp2f(-(float)f * (13.287712379549449f / 16.0f)); const float ang = (float)t * inv;
            float sn, cs; sincosf(ang, &sn, &cs); ROPE[t * 32 + f] = cs; ROPE[t * 32 + 16 + f] = sn; }
        __syncthreads();
        if (bx < 96) {
            float* MOD = WSP(float, WS_MOD);
            LAS float* scs = (LAS float*)lds;
            LAS float* part = scs + 1024 * 24;
            for (int i = tid; i < NSEQ * 1024; i += 512) { const int r = i >> 10, k = i & 1023; const float c = r < 8 ? ap->in[2][r * 1024 + k] : ap->in[3][(r - 8) * 1024 + k]; scs[k * 24 + r] = c * sigmoidf_(c); }
            __syncthreads();
            const int jc = tid & 63, ks = tid >> 6, jcol = bx * 64 + jc;
            f32x4 acc[6];
#pragma unroll
            for (int r = 0; r < 6; ++r) acc[r] = (f32x4){0.f, 0.f, 0.f, 0.f};
            const float* wp = ap->in[4] + (size_t)(ks * 128) * 6144 + jcol;
#pragma unroll 8
            for (int k = 0; k < 128; ++k) { const float w = wp[(size_t)k * 6144]; const LAS f32x4* sp4 = (const LAS f32x4*)(scs + (ks * 128 + k) * 24);
#pragma unroll
                for (int r = 0; r < 6; ++r) acc[r] += sp4[r] * w; }
#pragma unroll
            for (int r = 0; r < 6; ++r)
#pragma unroll
                for (int e = 0; e < 4; ++e) part[(ks * 24 + 4 * r + e) * 64 + jc] = acc[r][e];
            __syncthreads();
            for (int o = tid; o < 24 * 64; o += 512) { const int r = o >> 6, c = o & 63; float sum = 0.f;
#pragma unroll
                for (int k8 = 0; k8 < 8; ++k8) sum += part[(k8 * 24 + r) * 64 + c];
                MOD[r * 6144 + bx * 64 + c] = sum + ap->in[5][bx * 64 + c]; }
        }
    }
    grid.sync();
    const XcdBarrier xbar = xcd_barrier_post((unsigned*)(a.ws + WS_BAR), (volatile LAS unsigned*)(lds + 147456));
    {
        PHASE_BEGIN
        const float* MOD = WSP(float, WS_MOD); bf16_t* XN = WSP(bf16_t, WS_XN);
        for (int row = gw; row < MT; row += ngw) { const int sq = seq_of_row(row);
            adaln_row(row < MP ? ap->in[0] + (size_t)row * DM : ap->in[1] + (size_t)(row - MP) * DM, ap->in[6], MOD + sq * 6144 + 1024, MOD + sq * 6144, XN + (size_t)row * DM, lane); }
        { const bf16_t* Wf = WSP(bf16_t, WS_WFFI); float* C2 = WSP(float, WS_C2);
          for (int n = gw; n < 5632; n += ngw) {
              f32x4 w0, w1, w2, w3; unpack8(*(const u32x4*)(Wf + (size_t)n * 1024 + 16 * lane), w0, w1); unpack8(*(const u32x4*)(Wf + (size_t)n * 1024 + 16 * lane + 8), w2, w3);
              for (int b = 0; b < NSEQ; ++b) { const float* sp = MOD + b * 6144 + 3072 + 16 * lane;
                  const f32x4 h0 = *(const f32x4*)sp, h1 = *(const f32x4*)(sp + 4), h2 = *(const f32x4*)(sp + 8), h3 = *(const f32x4*)(sp + 12);
                  const f32x4 p = h0 * w0 + h1 * w1 + h2 * w2 + h3 * w3;
                  const float tot = sum64q((p[0] + p[1]) + (p[2] + p[3]));
                  if (lane == 0) C2[b * 5632 + n] = tot; } } }
    }
    xcd_barrier(xbar);
    {
        PHASE_BEGIN
        pg8::Gemm g{WSP(bf16_t, WS_XN), WSP(bf16_t, WS_WIN), MT, NPAD_IN, 1024, 1024, 1024}; pg8::StaticOrder S; S.init(MT, NPAD_IN, G, bx);
        EpiIn E{WSP(bf16_t, WS_PM), WSP(float, WS_SSQ), WSP(bf16_t, WS_KPE), WSP(bf16_t, WS_PR), (bf16_t*)ap->out, WSP(float, WS_ROPE)}; for (int rep = 0; rep < REP_P2; ++rep) pg8::gemm_phase<EpiIn, true>(lds, g, S, E);
    }
    xcd_barrier(xbar);
    { PHASE_BEGIN pg8::Gemm g{WSP(bf16_t, WS_PM), WSP(bf16_t, WS_WUQ), MT, 768, 384, 640, 384}; pg8::StaticOrder S; S.init(MT, 768, G, bx); EpiQ E{WSP(float, WS_SSQ), WSP(bf16_t, WS_Q)}; pg8::gemm_phase<EpiQ, true>(lds, g, S, E); }
    { PHASE_BEGIN pg8::Gemm g{WSP(bf16_t, WS_PM) + 384, WSP(bf16_t, WS_WK), MT, 512, 256, 640, 256}; pg8::StaticOrder S; S.init(MT, 512, G, bx); EpiK E{WSP(float, WS_SSQ), WSP(bf16_t, WS_KN)}; pg8::gemm_phase<EpiK, true>(lds, g, S, E); }
    { PHASE_BEGIN pg8::Gemm g{WSP(bf16_t, WS_WV), WSP(bf16_t, WS_PM) + 384, 512, MT, 256, 256, 640}; pg8::StaticOrder S; S.init(512, MT, G, bx); EpiVT E{WSP(float, WS_SSQ), WSP(bf16_t, WS_VT)}; pg8::gemm_phase<EpiVT, true>(lds, g, S, E); }
    xcd_barrier(xbar);
    {
        PHASE_BEGIN
        const bf16_t *Qb = WSP(bf16_t, WS_Q), *KN = WSP(bf16_t, WS_KN), *KPE = WSP(bf16_t, WS_KPE), *VT = WSP(bf16_t, WS_VT); bf16_t* Ob = WSP(bf16_t, WS_O); const float* ROPE = WSP(float, WS_ROPE);
        for (int rep = 0; rep < REP_ATT; ++rep) {
        for (int i = vcu; i < 2048; i += G) { const int bh = i >> 5, qb = i & 31; attn_unit((bh >> 3) * TP, TP, bh & 7, qb, Qb, KN, KPE, VT, Ob, ROPE, lds); }
        for (int i = vcu; i < 1024; i += G) { const int bh = i >> 3, qb = i & 7; attn_unit(MP + (bh >> 3) * TS, TS, bh & 7, qb, Qb, KN, KPE, VT, Ob, ROPE, lds); }
        }
    }
    {
        PHASE_BEGIN
        const bf16_t* PR = WSP(bf16_t, WS_PR); bf16_t* TA = WSP(bf16_t, WS_TA); bf16_t* SG = WSP(bf16_t, WS_SG); const float* mu = ap->in[12];
        for (int i = bx * 512 + tid; i < MT * 32; i += G * 512) { const int row = i >> 5, c8 = (i & 31) * 8; const int t = pos_of_row(row), T = len_of_row(row);
            const bf16_t* pp = PR + (size_t)row * 1792 + 1536 + c8; const u32x4 z = {0u, 0u, 0u, 0u};
            const u32x4 x0 = *(const u32x4*)pp, xm = t > 0 ? *(const u32x4*)(pp - 1792) : z, xp = t < T - 1 ? *(const u32x4*)(pp + 1792) : z;
            f32x4 a0_, a1_, m0_, m1_, p0_, p1_; unpack8(x0, a0_, a1_); unpack8(xm, m0_, m1_); unpack8(xp, p0_, p1_);
            const f32x4 mu0 = *(const f32x4*)(mu + 1536 + c8), mu1 = *(const f32x4*)(mu + 1536 + c8 + 4);
            f32x4 r0 = a0_ + mu0 * ((m0_ + p0_) * 0.5f - a0_), r1 = a1_ + mu1 * ((m1_ + p1_) * 0.5f - a1_);
            if (c8 < 64) {
#pragma unroll
                for (int e = 0; e < 4; ++e) { r0[e] = tanh_fast(r0[e]); r1[e] = tanh_fast(r1[e]); } }
            else if (c8 >= 128) {
#pragma unroll
                for (int e = 0; e < 4; ++e) { r0[e] = sigmoidf_(r0[e]); r1[e] = sigmoidf_(r1[e]); } }
            if (c8 < 128) *(u32x4*)(TA + (size_t)row * 128 + c8) = pack8(r0, r1); else *(u32x4*)(SG + (size_t)row * 128 + (c8 - 128)) = pack8(r0, r1); }
    }
    xcd_barrier(xbar);
    {
        PHASE_BEGIN
        const ScanW W{ap->in[12], ap->in[13], ap->in[14], ap->in[15], ap->in[16], ap->in[18], ap->in[19], ap->in[20]};
        for (int rep = 0; rep < REP_SCAN; ++rep)
        for (int i = bx; i < 256; i += G)
        for (int sub = 0; sub < (i < 128 ? 1 : 2); ++sub) {
            int row0, T, h, dir;
            if (i < 128) { const int b = i >> 4; h = (i >> 1) & 7; dir = i & 1; row0 = b * TP; T = TP; }
            else { const int k = 2 * (i - 128) + sub; const int b = k >> 4; h = (k >> 1) & 7; dir = k & 1; row0 = MP + b * TS; T = TS; }
            scan_chain(row0, T, h, dir, WSP(bf16_t, WS_PR), WSP(bf16_t, WS_TA), W, dir ? WSP(bf16_t, WS_Y1) : WSP(bf16_t, WS_Y0), WSP(float, WS_BON), (LAS float*)lds);
            __syncthreads();
        }
    }
    if (G > 128 && bx >= 128) { PHASE_BEGIN pg8::Gemm g{WSP(bf16_t, WS_O), WSP(bf16_t, WS_WMO), MT, 1024, 512, 512, 512}; pg8::StaticOrder S; S.init(MT, 1024, G - 128, bx - 128);
        EpiMo E{(const bf16_t*)ap->out, WSP(bf16_t, WS_T1A), WSP(bf16_t, WS_T1B)}; pg8::gemm_phase<EpiMo, true>(lds, g, S, E); }
    if (G > 128 && bx >= 128) { PHASE_BEGIN pg8::Gemm g{WSP(bf16_t, WS_SG), WSP(bf16_t, WS_WG), MT, 512, 128, 128, 128}; pg8::StaticOrder S; S.init(MT, 512, G - 128, bx - 128); EpiG E{WSP(bf16_t, WS_G)}; pg8::gemm_phase<EpiG, true>(lds, g, S, E); }
    else if (G <= 128) { PHASE_BEGIN pg8::Gemm g{WSP(bf16_t, WS_SG), WSP(bf16_t, WS_WG), MT, 512, 128, 128, 128}; pg8::StaticOrder S; S.init(MT, 512, G, bx); EpiG E{WSP(bf16_t, WS_G)}; pg8::gemm_phase<EpiG, true>(lds, g, S, E); }
    if (G <= 128) { PHASE_BEGIN pg8::Gemm g{WSP(bf16_t, WS_O), WSP(bf16_t, WS_WMO), MT, 1024, 512, 512, 512}; pg8::StaticOrder S; S.init(MT, 1024, G, bx);
        EpiMo E{(const bf16_t*)ap->out, WSP(bf16_t, WS_T1A), WSP(bf16_t, WS_T1B)}; pg8::gemm_phase<EpiMo, true>(lds, g, S, E); }
    xcd_barrier(xbar);
    {
        PHASE_BEGIN
        const bf16_t *Y0 = WSP(bf16_t, WS_Y0), *Y1 = WSP(bf16_t, WS_Y1); const float* BON = WSP(float, WS_BON); const bf16_t* PR = WSP(bf16_t, WS_PR); bf16_t* Gb = WSP(bf16_t, WS_G);
        const float *mu = ap->in[12], *lnw = ap->in[21], *lnb = ap->in[22];
        for (int row = gw; row < MT; row += ngw) {
            const int hh = lane >> 3, c0 = lane * 8; const int t = pos_of_row(row), T = len_of_row(row);
            f32x4 ya, yb, yc, yd; unpack8(*(const u32x4*)(Y0 + (size_t)row * 512 + c0), ya, yb); unpack8(*(const u32x4*)(Y1 + (size_t)row * 512 + c0), yc, yd);
            ya = ya + yc; yb = yb + yd;
            float s = (ya[0] + ya[1]) + (ya[2] + ya[3]) + (yb[0] + yb[1]) + (yb[2] + yb[3]);
            s = sum8(s);
            const float mean = s * (1.0f / 64.0f); ya = ya - mean; yb = yb - mean;
            float q = (ya[0] * ya[0] + ya[1] * ya[1]) + (ya[2] * ya[2] + ya[3] * ya[3]) + (yb[0] * yb[0] + yb[1] * yb[1]) + (yb[2] * yb[2] + yb[3] * yb[3]);
            q = sum8(q);
            const float rstd = rsqrtf(q * (1.0f / 64.0f) + LNX_EPS);
            const bf16_t* pp = PR + (size_t)row * 1792 + 1024 + c0; const u32x4 z = {0u, 0u, 0u, 0u};
            const u32x4 x0 = *(const u32x4*)pp, xm = t > 0 ? *(const u32x4*)(pp - 1792) : z, xp = t < T - 1 ? *(const u32x4*)(pp + 1792) : z;
            f32x4 a0_, a1_, m0_, m1_, p0_, p1_; unpack8(x0, a0_, a1_); unpack8(xm, m0_, m1_); unpack8(xp, p0_, p1_);
            const f32x4 mu0 = *(const f32x4*)(mu + 1024 + c0), mu1 = *(const f32x4*)(mu + 1024 + c0 + 4);
            const f32x4 v0 = a0_ + mu0 * ((m0_ + p0_) * 0.5f - a0_), v1 = a1_ + mu1 * ((m1_ + p1_) * 0.5f - a1_);
            const float bon = BON[(size_t)row * 8 + hh] + BON[((size_t)MT + row) * 8 + hh];
            const f32x4 lw0 = *(const f32x4*)(lnw + c0), lw1 = *(const f32x4*)(lnw + c0 + 4), lb0 = *(const f32x4*)(lnb + c0), lb1 = *(const f32x4*)(lnb + c0 + 4);
            f32x4 g0, g1; unpack8(*(const u32x4*)(Gb + (size_t)row * 512 + c0), g0, g1);
            const f32x4 o0 = (ya * rstd * lw0 + lb0 + v0 * bon) * g0, o1 = (yb * rstd * lw1 + lb1 + v1 * bon) * g1;
            *(u32x4*)(Gb + (size_t)row * 512 + c0) = pack8(o0, o1);
        }
    }
    xcd_barrier(xbar);
    { PHASE_BEGIN pg8::Gemm g{WSP(bf16_t, WS_G), WSP(bf16_t, WS_WRO), MT, 1024, 512, 512, 512}; pg8::StaticOrder S; S.init(MT, 1024, G, bx); EpiRo E{(const bf16_t*)ap->out, WSP(bf16_t, WS_T1A), WSP(bf16_t, WS_T1B), WSP(bf16_t, WS_MIX)}; pg8::gemm_phase<EpiRo, true>(lds, g, S, E); }
    xcd_barrier(xbar);
    { PHASE_BEGIN pg8::Gemm g{WSP(bf16_t, WS_MIX), WSP(bf16_t, WS_WOUT), MT, 1024, 1024, 1024, 1024}; pg8::StaticOrder S; S.init(MT, 1024, G, bx); EpiRes2 E{ap->in[0], ap->in[1], ap->out, WSP(float, WS_MOD), ap->in[26], WSP(bf16_t, WS_XN2), WSP(float, WS_SSQ2)}; pg8::gemm_phase<EpiRes2, true>(lds, g, S, E); }
    xcd_barrier(xbar);
    { PHASE_BEGIN pg8::Gemm g{WSP(bf16_t, WS_XN2), WSP(bf16_t, WS_WFFI), MT, 5632, 1024, 1024, 1024}; pg8::StaticOrder S; S.init(MT, 5632, G, bx); EpiFfn E{WSP(bf16_t, WS_H), WSP(float, WS_SSQ2), WSP(float, WS_C2)}; for (int rep = 0; rep < REP_FFN; ++rep) pg8::gemm_phase<EpiFfn, true>(lds, g, S, E); }
    xcd_barrier(xbar);
    { PHASE_BEGIN pg8::Gemm g{WSP(bf16_t, WS_H), WSP(bf16_t, WS_WFFO), MT, 1024, DFF, DFF, DFF}; pg8::StaticOrder S; S.init(MT, 1024, G, bx); EpiRes E{ap->out, ap->out + (size_t)MP * 1024, ap->out, WSP(float, WS_MOD) + 5120}; pg8::gemm_phase<EpiRes, true>(lds, g, S, E); }
    xcd_barrier(xbar);
    {
        PHASE_BEGIN
        const float* fn = ap->in[29];
        for (int row = gw; row < MT; row += ngw) {
            float* xr = ap->out + (size_t)row * DM; f32x4 v[4]; float s = 0.f;
#pragma unroll
            for (int j = 0; j < 4; ++j) { v[j] = *(const f32x4*)(xr + 4 * lane + 256 * j); s += (v[j][0] * v[j][0] + v[j][1] * v[j][1]) + (v[j][2] * v[j][2] + v[j][3] * v[j][3]); }
            const float rstd = rsqrtf(sum64q(s) * (1.0f / DM) + EPS);
#pragma unroll
            for (int j = 0; j < 4; ++j) { const f32x4 g = *(const f32x4*)(fn + 4 * lane + 256 * j); *(f32x4*)(xr + 4 * lane + 256 * j) = v[j] * rstd * g; }
        }
    }
}

extern "C" void kernel_launch(void* const* d_in, const int* in_sizes, int n_in, void* d_out, int out_size, void* d_ws, size_t ws_size, hipStream_t stream) {
    static int grid = 0;
    if (grid == 0) {
        if (n_in != 30 || out_size != MT * DM || ws_size < WS_END) { fprintf(stderr, "kernel_launch: unexpected shapes (n_in %d out %d ws %zu)\n", n_in, out_size, ws_size); grid = -1; return; }
        int dev = 0, cus = 0, per_cu = 0;
        hipGetDevice(&dev); hipDeviceGetAttribute(&cus, hipDeviceAttributeMultiprocessorCount, dev);
        if (hipFuncSetAttribute((const void*)fwd_kernel, hipFuncAttributeMaxDynamicSharedMemorySize, LDS_BYTES) != hipSuccess) { fprintf(stderr, "kernel_launch: hipFuncSetAttribute failed\n"); grid = -1; return; }
        hipOccupancyMaxActiveBlocksPerMultiprocessor(&per_cu, (const void*)fwd_kernel, 512, LDS_BYTES);
        (void)hipGetLastError();
        if (per_cu < 1) per_cu = 1;
        grid = cus * 1;
        fprintf(stderr, "kernel_launch: cus %d per_cu %d grid %d\n", cus, per_cu, grid);
    }
    if (grid < 0) return;
    Args a{};
    for (int i = 0; i < 30; ++i) a.in[i] = (const float*)d_in[i];
    a.out = (float*)d_out; a.ws = (unsigned char*)d_ws;
    void* args[] = {&a};
    hipError_t e = hipLaunchCooperativeKernel((const void*)fwd_kernel, dim3(grid), dim3(512), args, LDS_BYTES, stream);
    if (e != hipSuccess) fprintf(stderr, "cooperative launch failed: %s (grid %d)\n", hipGetErrorString(e), grid);
}
```

```cpp
#include <hip/hip_runtime.h>
#include <hip/hip_cooperative_groups.h>
#include <cstdio>
#include <cstdint>
namespace cg = cooperative_groups;

#define LAS __attribute__((address_space(3)))
typedef unsigned short bf16_t;
typedef short bf16x8 __attribute__((ext_vector_type(8)));
typedef float f32x4 __attribute__((ext_vector_type(4)));
typedef float f32x2 __attribute__((ext_vector_type(2)));
typedef float f32x16 __attribute__((ext_vector_type(16)));
typedef unsigned u32x4 __attribute__((ext_vector_type(4)));
typedef unsigned u32x2 __attribute__((ext_vector_type(2)));

constexpr int DM = 1024, MP = 65536, MS = 32768, MT = MP + MS;
constexpr int TP = 8192, TS = 2048, NSEQ = 24;
constexpr int NPAD_IN = 4608, DFF = 2816;
constexpr float EPS = 1e-6f, LNX_EPS = 64e-5f;
constexpr float QSCALE = 0.10206207261596575f * 1.4426950408889634f;

constexpr size_t MiB = 1u << 20;
constexpr size_t WS_MOD = 0, WS_ROPE = 1 * MiB;
constexpr size_t WS_WIN = 2 * MiB, WS_WUQ = 11 * MiB, WS_WK = 12 * MiB, WS_WV = WS_WK + 512 * 1024, WS_WG = 13 * MiB, WS_WMO = 14 * MiB, WS_WRO = 15 * MiB,
                 WS_WOUT = 16 * MiB, WS_WFFI = 18 * MiB, WS_WFFO = 29 * MiB;
constexpr size_t WS_SSQ = 35 * MiB;
constexpr size_t WS_KPE = 43 * MiB;
constexpr size_t WS_BIG = 50 * MiB;
constexpr size_t WS_XN = WS_BIG, WS_Q = WS_BIG, WS_Y0 = WS_BIG, WS_XN2 = WS_BIG;
constexpr size_t WS_T1A = WS_BIG + 96 * MiB, WS_T1B = WS_BIG + 744 * MiB;
constexpr size_t WS_PM = WS_BIG + 192 * MiB, WS_G = WS_PM, WS_TA = WS_PM + 96 * MiB;
constexpr size_t WS_PR = WS_BIG + 312 * MiB, WS_MIX = WS_PR;
constexpr size_t WS_KN = WS_BIG + 648 * MiB, WS_VT = WS_KN + 96 * MiB, WS_Y1 = WS_KN;
constexpr size_t WS_O = WS_BIG + 840 * MiB;
constexpr size_t WS_SG = WS_BIG + 936 * MiB;
constexpr size_t WS_BON = WS_BIG + 960 * MiB;
constexpr size_t WS_H = WS_BIG + 384 * MiB;
constexpr size_t WS_BAR = 1016 * MiB;
constexpr size_t WS_SSQ2 = 1017 * MiB;
constexpr size_t WS_C2 = 1018 * MiB;
constexpr size_t WS_END = 1019 * MiB;

__device__ __forceinline__ unsigned cvtpk(float lo, float hi) { typedef __bf16 bf2 __attribute__((ext_vector_type(2))); f32x2 v = {lo, hi}; bf2 b = __builtin_convertvector(v, bf2); return __builtin_bit_cast(unsigned, b); }
__device__ __forceinline__ float bflo(unsigned w) { return __uint_as_float(w << 16); }
__device__ __forceinline__ float bfhi(unsigned w) { return __uint_as_float(w & 0xffff0000u); }
__device__ __forceinline__ float bf2f(bf16_t u) { return __uint_as_float((unsigned)u << 16); }
__device__ __forceinline__ u32x4 pack8(f32x4 a, f32x4 b) { u32x4 w; w.x = cvtpk(a[0], a[1]); w.y = cvtpk(a[2], a[3]); w.z = cvtpk(b[0], b[1]); w.w = cvtpk(b[2], b[3]); return w; }
__device__ __forceinline__ void unpack8(u32x4 w, f32x4& a, f32x4& b) { a = (f32x4){bflo(w.x), bfhi(w.x), bflo(w.y), bfhi(w.y)}; b = (f32x4){bflo(w.z), bfhi(w.z), bflo(w.w), bfhi(w.w)}; }
__device__ __forceinline__ float wave_sum(float v) {
#pragma unroll
    for (int o = 1; o < 64; o <<= 1) v += __shfl_xor(v, o);
    return v;
}
__device__ __forceinline__ float max3f(float a, float b, float c) { float r; asm("v_max3_f32 %0, %1, %2, %3" : "=v"(r) : "v"(a), "v"(b), "v"(c)); return r; }
template <int CTRL> __device__ __forceinline__ float dpp_f(float x) { return __int_as_float(__builtin_amdgcn_update_dpp(0, __float_as_int(x), CTRL, 0xf, 0xf, true)); }
__device__ __forceinline__ float sum8(float x) { x += dpp_f<0xB1>(x); x += dpp_f<0x4E>(x); x += dpp_f<0x141>(x); return x; }
__device__ __forceinline__ float sum64q(float x) {
    x += dpp_f<0xB1>(x); x += dpp_f<0x4E>(x); x += dpp_f<0x141>(x); x += dpp_f<0x140>(x);
    return __int_as_float(__builtin_amdgcn_readlane(__float_as_int(x), 0)) + __int_as_float(__builtin_amdgcn_readlane(__float_as_int(x), 16)) + __int_as_float(__builtin_amdgcn_readlane(__float_as_int(x), 32)) + __int_as_float(__builtin_amdgcn_readlane(__float_as_int(x), 48)); }
__device__ __forceinline__ float sum_rows4(float x) {
    auto r16 = __builtin_amdgcn_permlane16_swap(__float_as_uint(x), __float_as_uint(x), false, false); x = __uint_as_float(r16[0]) + __uint_as_float(r16[1]);
    auto r32 = __builtin_amdgcn_permlane32_swap(__float_as_uint(x), __float_as_uint(x), false, false); return __uint_as_float(r32[0]) + __uint_as_float(r32[1]); }
__device__ __forceinline__ float tanh_fast(float x) { const float e = __expf(2.0f * x); return 1.0f - 2.0f * __builtin_amdgcn_rcpf(1.0f + e); }
__device__ __forceinline__ float sigmoidf_(float x) { return __builtin_amdgcn_rcpf(1.0f + __expf(-x)); }
__device__ __forceinline__ int seq_of_row(int row) { return row < MP ? (row >> 13) : 8 + ((row - MP) >> 11); }
__device__ __forceinline__ int pos_of_row(int row) { return row < MP ? (row & (TP - 1)) : (row & (TS - 1)); }
__device__ __forceinline__ int len_of_row(int row) { return row < MP ? TP : TS; }

namespace pg8 {
constexpr int BM = 256, BK = 64, HALF = 128, HTB = HALF * BK * 2, STAGE_BYTES = 8 * HTB, NXCD = 8, WGM = 8;
__host__ __device__ __forceinline__ int lds_byte(int r, int c) { const int st = (r >> 4) * 2 + (c >> 5), rr = r & 15, cc = c & 31, ob = rr * 64 + cc * 2; return st * 1024 + (ob ^ (((ob >> 9) & 1) << 5)); }
__host__ __device__ __forceinline__ void stage_rc(int b, int& R, int& C) { const int st = b / 1024, sb = b % 1024, swz = sb ^ (((sb >> 9) & 1) << 5); R = (st >> 1) * 16 + swz / 64; C = (st & 1) * 32 + (swz % 64) / 2; }
__host__ __device__ __forceinline__ int perm32(int rho) { const int n = rho >> 4, i = rho & 15; return 8 * (i >> 2) + 4 * n + (i & 3); }
struct Unit { int pm, pn; };
struct Gemm { const bf16_t* A; const bf16_t* Bt; int M, N, K, lda, ldb; };
struct StaticOrder {
    int nM, nN, nwg, G, c;
    __device__ void init(int M, int N, int G_, int c_) { nM = M / BM; nN = N / BM; nwg = nM * nN; G = G_; c = c_; }
    __device__ bool next(int i, Unit& u) const {
        const long L = (long)i * G + c; if (L >= nwg) return false;
        int wgid = (int)L; { const int q = nwg / NXCD, r = nwg % NXCD, xcd = wgid % NXCD, off = wgid / NXCD; wgid = (xcd < r ? xcd * (q + 1) : r * (q + 1) + (xcd - r) * q) + off; }
        const int nig = WGM * nN, gid = wgid / nig, fm = gid * WGM, gsz = (nM - fm) < WGM ? (nM - fm) : WGM;
        u.pm = fm + ((wgid % nig) % gsz); u.pn = (wgid % nig) / gsz; return true;
    }
};
template <class Epi, bool ALIGN_EPI>
__device__ __forceinline__ void gemm_phase(LAS unsigned char* lds, const Gemm g, const StaticOrder& S, const Epi& E) {
    int tid = threadIdx.x; asm volatile("" : "+v"(tid));
    const int wid = __builtin_amdgcn_readfirstlane(tid >> 6), lane = tid & 63, wr = wid >> 2, wc = wid & 3, fr = lane & 15, fq = lane >> 4;
    const int K = g.K, nt = K / BK;
    unsigned voffA[2], voffB[2];
#pragma unroll
    for (int i = 0; i < 2; ++i) { int R, C; stage_rc(tid * 16 + i * 8192, R, C); const int Rb = (R & ~31) + perm32(R & 31);
        voffA[i] = (unsigned)(R * g.lda + C) * 2u; voffB[i] = (unsigned)(Rb * g.ldb + C) * 2u; }
    const size_t kstep = (size_t)(BK * 2);
    const size_t hstepA = (size_t)HALF * g.lda * 2, hstepB = (size_t)HALF * g.ldb * 2;
    const size_t tstepA = 2 * hstepA, tstepB = 2 * hstepB;
    const unsigned ldsw = (unsigned)wid * 1024u;
    const int aoff = lds_byte(wr * 64 + fr, fq * 8), boff = lds_byte(wc * 32 + fr, fq * 8);
#define PG8_SA(b, h) (((b) * 2 + (h)) * HTB)
#define PG8_SB(b, h) ((4 + (b) * 2 + (h)) * HTB)
#define PG8_STAGE(bufoff, gbase, voff) do { _Pragma("unroll") for (int _i = 0; _i < 2; ++_i) \
        __builtin_amdgcn_global_load_lds((const unsigned*)((const char*)(gbase) + (voff)[_i]), (LAS unsigned*)(lds + (bufoff) + ldsw + _i * 8192), 16, 0, 0); } while (0)
#define PG8_LDA(dst, b, h) do { _Pragma("unroll") for (int m = 0; m < 4; ++m) _Pragma("unroll") for (int k = 0; k < 2; ++k) dst[m][k] = *(const LAS bf16x8*)(lds + PG8_SA(b, h) + aoff + m * 2048 + k * 1024); } while (0)
#define PG8_LDB(dst, b, h) do { _Pragma("unroll") for (int n = 0; n < 2; ++n) _Pragma("unroll") for (int k = 0; k < 2; ++k) dst[n][k] = *(const LAS bf16x8*)(lds + PG8_SB(b, h) + boff + n * 2048 + k * 1024); } while (0)
#define PG8_MMA(ai, bj, At, Bt) do { __builtin_amdgcn_s_setprio(1); _Pragma("unroll") for (int m = 0; m < 4; ++m) _Pragma("unroll") for (int n = 0; n < 2; ++n) _Pragma("unroll") for (int k = 0; k < 2; ++k) \
        acc[ai][bj][m][n] = __builtin_amdgcn_mfma_f32_16x16x32_bf16(Bt[n][k], At[m][k], acc[ai][bj][m][n], 0, 0, 0); __builtin_amdgcn_s_setprio(0); } while (0)
#define PG8_WAIT_V(n) asm volatile("s_waitcnt vmcnt(" #n ")" ::: "memory")
#define PG8_WAIT_L(n) asm volatile("s_waitcnt lgkmcnt(" #n ")" ::: "memory")
#define PG8_BAR __builtin_amdgcn_s_barrier()
#define PG8_SCHED __builtin_amdgcn_sched_barrier(0)
    Unit cur, nxt; int ui = 0;
    if (!S.next(0, cur)) return;
    f32x4 acc[2][2][4][2];
#pragma unroll
    for (int a = 0; a < 2; ++a)
#pragma unroll
        for (int b = 0; b < 2; ++b)
#pragma unroll
            for (int m = 0; m < 4; ++m)
#pragma unroll
                for (int n = 0; n < 2; ++n) acc[a][b][m][n] = (f32x4){0.f, 0.f, 0.f, 0.f};
    bf16x8 At[4][2], B0[2][2], B1[2][2];
    const char* cA = (const char*)g.A + (size_t)cur.pm * tstepA; const char* cB = (const char*)g.Bt + (size_t)cur.pn * tstepB;
    PG8_STAGE(PG8_SB(0, 0), cB, voffB); PG8_STAGE(PG8_SB(0, 1), cB + hstepB, voffB); PG8_STAGE(PG8_SA(0, 0), cA, voffA); PG8_STAGE(PG8_SA(0, 1), cA + hstepA, voffA);
    if (wr == 1) PG8_BAR;
    PG8_WAIT_V(2); PG8_BAR;
    PG8_STAGE(PG8_SB(1, 0), cB + kstep, voffB); PG8_STAGE(PG8_SA(1, 0), cA + kstep, voffA); PG8_STAGE(PG8_SB(1, 1), cB + hstepB + kstep, voffB);
    PG8_WAIT_V(6); PG8_BAR;
    for (;;) {
        const bool has_next = S.next(ui + 1, nxt);
        const char* nA = has_next ? (const char*)g.A + (size_t)nxt.pm * tstepA : cA; const char* nB = has_next ? (const char*)g.Bt + (size_t)nxt.pn * tstepB : cB;
        for (int t = 0; t < nt; t += 2) {
            const bool last = (t == nt - 2);
            const char* a1 = cA + (size_t)(t + 1) * kstep;
            const char* a2 = last ? nA : cA + (size_t)(t + 2) * kstep; const char* b2 = last ? nB : cB + (size_t)(t + 2) * kstep;
            const char* a3 = a2 + kstep; const char* b3 = b2 + kstep;
            PG8_LDB(B0, 0, 0); PG8_LDB(B1, 0, 1); PG8_SCHED; PG8_LDA(At, 0, 0); PG8_STAGE(PG8_SA(1, 1), a1 + hstepA, voffA);
            PG8_WAIT_V(8); PG8_WAIT_L(0); PG8_BAR; PG8_MMA(0, 0, At, B0); PG8_MMA(0, 1, At, B1); PG8_BAR; PG8_SCHED;
            PG8_LDA(At, 0, 1); PG8_STAGE(PG8_SB(0, 0), b2, voffB); PG8_STAGE(PG8_SB(0, 1), b2 + hstepB, voffB); PG8_STAGE(PG8_SA(0, 0), a2, voffA);
            PG8_WAIT_V(8); PG8_WAIT_L(0); PG8_BAR; PG8_MMA(1, 0, At, B0); PG8_MMA(1, 1, At, B1); PG8_BAR; PG8_SCHED;
            PG8_LDB(B0, 1, 0); PG8_LDB(B1, 1, 1); PG8_SCHED; PG8_LDA(At, 1, 0); PG8_STAGE(PG8_SA(0, 1), a2 + hstepA, voffA);
            PG8_WAIT_V(8); PG8_WAIT_L(0); PG8_BAR; PG8_MMA(0, 0, At, B0); PG8_MMA(0, 1, At, B1); PG8_BAR; PG8_SCHED;
            PG8_LDA(At, 1, 1); PG8_STAGE(PG8_SB(1, 0), b3, voffB); PG8_STAGE(PG8_SB(1, 1), b3 + hstepB, voffB); PG8_STAGE(PG8_SA(1, 0), a3, voffA);
            PG8_WAIT_V(8); PG8_WAIT_L(0); PG8_BAR; PG8_MMA(1, 0, At, B0); PG8_MMA(1, 1, At, B1); PG8_BAR; PG8_SCHED;
        }
        if constexpr (ALIGN_EPI) { if (wr == 0) PG8_BAR; }
        { int t2 = threadIdx.x; asm volatile("" : "+v"(t2));
          const int w2 = __builtin_amdgcn_readfirstlane(t2 >> 6), l2 = t2 & 63; E(acc, cur, w2 >> 2, w2 & 3, l2 & 15, l2 >> 4); }
        if (!has_next) break;
#pragma unroll
        for (int a = 0; a < 2; ++a)
#pragma unroll
            for (int b = 0; b < 2; ++b)
#pragma unroll
                for (int m = 0; m < 4; ++m)
#pragma unroll
                    for (int n = 0; n < 2; ++n) acc[a][b][m][n] = (f32x4){0.f, 0.f, 0.f, 0.f};
        cur = nxt; cA = nA; cB = nB; ++ui;
        if constexpr (ALIGN_EPI) { if (wr == 1) PG8_BAR; }
    }
    PG8_WAIT_V(0);
    if constexpr (!ALIGN_EPI) { if (wr == 0) PG8_BAR; }
    PG8_BAR;
#undef PG8_SA
#undef PG8_SB
#undef PG8_STAGE
#undef PG8_LDA
#undef PG8_LDB
#undef PG8_MMA
#undef PG8_WAIT_V
#undef PG8_WAIT_L
#undef PG8_BAR
#undef PG8_SCHED
}
}
using pg8::Unit;

#define EPI_ROWS(ai, m) (u.pm * 256 + (ai) * 128 + wr * 64 + (m) * 16 + fr)
#define EPI_COL(bj) (u.pn * 256 + (bj) * 128 + wc * 32 + 8 * fq)
typedef const f32x4 (&AccRef)[2][2][4][2];

__device__ __forceinline__ void rope8(f32x4& v0, f32x4& v1, const float* ropeRow, int fq) {
    const int i0 = 8 * (fq & 1);
    const f32x4 c0 = *(const f32x4*)(ropeRow + i0), c1 = *(const f32x4*)(ropeRow + i0 + 4), s0 = *(const f32x4*)(ropeRow + 16 + i0), s1 = *(const f32x4*)(ropeRow + 16 + i0 + 4);
    f32x4 o0, o1;
#pragma unroll
    for (int e = 0; e < 4; ++e) { o0[e] = __shfl_xor(v0[e], 32); o1[e] = __shfl_xor(v1[e], 32); }
    if (fq < 2) { v0 = v0 * c0 - o0 * s0; v1 = v1 * c1 - o1 * s1; }
    else        { v0 = v0 * c0 + o0 * s0; v1 = v1 * c1 + o1 * s1; }
}

struct EpiIn {
    bf16_t* PM; float* SSQ; bf16_t* KPE; bf16_t* PR; bf16_t* GS; const float* rope;
    __device__ __forceinline__ void operator()(AccRef acc, const Unit& u, int wr, int wc, int fr, int fq) const {
#pragma unroll
        for (int bj = 0; bj < 2; ++bj) {
            const int cgp = u.pn * 256 + bj * 128 + wc * 32;
            if (cgp >= 672 && cgp < 768) continue;
#pragma unroll
            for (int ai = 0; ai < 2; ++ai)
#pragma unroll
                for (int m = 0; m < 4; ++m) {
                    const int row = EPI_ROWS(ai, m);
                    f32x4 v0 = acc[ai][bj][m][0], v1 = acc[ai][bj][m][1];
                    if (cgp < 640) {
                        *(u32x4*)(PM + (size_t)row * 640 + cgp + 8 * fq) = pack8(v0, v1);
                        float s = (v0[0] * v0[0] + v0[1] * v0[1]) + (v0[2] * v0[2] + v0[3] * v0[3]) + (v1[0] * v1[0] + v1[1] * v1[1]) + (v1[2] * v1[2] + v1[3] * v1[3]);
                        s += __shfl_xor(s, 16); s += __shfl_xor(s, 32);
                        if (fq == 0) SSQ[(size_t)row * 20 + (cgp >> 5)] = s;
                    } else if (cgp == 640) {
                        rope8(v0, v1, rope + pos_of_row(row) * 32, fq);
                        *(u32x4*)(KPE + (size_t)row * 32 + 8 * fq) = pack8(v0, v1);
                    } else if (cgp < 2560) {
                        *(u32x4*)(PR + (size_t)row * 1792 + (cgp - 768) + 8 * fq) = pack8(v0, v1);
                    } else {
#pragma unroll
                        for (int e = 0; e < 4; ++e) { v0[e] = sigmoidf_(v0[e]); v1[e] = sigmoidf_(v1[e]); }
                        *(u32x4*)(GS + (size_t)row * 2048 + (cgp - 2560) + 8 * fq) = pack8(v0, v1);
                    }
                }
        }
    }
};
struct EpiQ {
    const float* SSQ; bf16_t* Q;
    __device__ __forceinline__ void operator()(AccRef acc, const Unit& u, int wr, int wc, int fr, int fq) const {
#pragma unroll
        for (int ai = 0; ai < 2; ++ai)
#pragma unroll
            for (int m = 0; m < 4; ++m) {
                const int row = EPI_ROWS(ai, m);
                const float* sp = SSQ + (size_t)row * 20; float s = 0.f;
#pragma unroll
                for (int g4 = 0; g4 < 3; ++g4) { const f32x4 t = *(const f32x4*)(sp + 4 * g4); s += (t[0] + t[1]) + (t[2] + t[3]); asm volatile("" : "+v"(s) :: "memory"); }
                const float sc = rsqrtf(s * (1.0f / 384.0f) + EPS) * QSCALE;
#pragma unroll
                for (int bj = 0; bj < 2; ++bj) {
                    f32x4 v0 = acc[ai][bj][m][0] * sc, v1 = acc[ai][bj][m][1] * sc;
                    *(u32x4*)(Q + (size_t)row * 768 + EPI_COL(bj)) = pack8(v0, v1);
                }
            }
    }
};
struct EpiK {
    const float* SSQ; bf16_t* KN;
    __device__ __forceinline__ void operator()(AccRef acc, const Unit& u, int wr, int wc, int fr, int fq) const {
#pragma unroll
        for (int ai = 0; ai < 2; ++ai)
#pragma unroll
            for (int m = 0; m < 4; ++m) {
                const int row = EPI_ROWS(ai, m);
                const float* sp = SSQ + (size_t)row * 20 + 12; float s = 0.f;
#pragma unroll
                for (int g4 = 0; g4 < 2; ++g4) { const f32x4 t = *(const f32x4*)(sp + 4 * g4); s += (t[0] + t[1]) + (t[2] + t[3]); }
                const float sc = rsqrtf(s * (1.0f / 256.0f) + EPS);
#pragma unroll
                for (int bj = 0; bj < 2; ++bj)
                    *(u32x4*)(KN + (size_t)row * 512 + EPI_COL(bj)) = pack8(acc[ai][bj][m][0] * sc, acc[ai][bj][m][1] * sc);
            }
    }
};
struct EpiVT {
    const float* SSQ; bf16_t* VT;
    __device__ __forceinline__ void operator()(AccRef acc, const Unit& u, int wr, int wc, int fr, int fq) const {
#pragma unroll
        for (int bj = 0; bj < 2; ++bj) {
            const int tok0 = EPI_COL(bj);
            f32x4 sc0, sc1;
#pragma unroll
            for (int e = 0; e < 8; ++e) {
                const float* sp = SSQ + (size_t)(tok0 + e) * 20 + 12;
                const f32x4 t0 = *(const f32x4*)sp, t1 = *(const f32x4*)(sp + 4);
                const float s = ((t0[0] + t0[1]) + (t0[2] + t0[3])) + ((t1[0] + t1[1]) + (t1[2] + t1[3]));
                const float sc = rsqrtf(s * (1.0f / 256.0f) + EPS);
                if (e < 4) sc0[e] = sc; else sc1[e - 4] = sc;
            }
#pragma unroll
            for (int ai = 0; ai < 2; ++ai)
#pragma unroll
                for (int m = 0; m < 4; ++m) {
                    const int row = EPI_ROWS(ai, m);
                    *(u32x4*)(VT + (size_t)row * MT + tok0) = pack8(acc[ai][bj][m][0] * sc0, acc[ai][bj][m][1] * sc1);
                }
        }
    }
};
struct EpiG {
    bf16_t* G;
    __device__ __forceinline__ void operator()(AccRef acc, const Unit& u, int wr, int wc, int fr, int fq) const {
#pragma unroll
        for (int ai = 0; ai < 2; ++ai)
#pragma unroll
            for (int m = 0; m < 4; ++m) { const int row = EPI_ROWS(ai, m);
#pragma unroll
                for (int bj = 0; bj < 2; ++bj) *(u32x4*)(G + (size_t)row * 512 + EPI_COL(bj)) = pack8(acc[ai][bj][m][0], acc[ai][bj][m][1]); }
    }
};
struct EpiMo {
    const bf16_t* GS; bf16_t* T1A; bf16_t* T1B;
    __device__ __forceinline__ void operator()(AccRef acc, const Unit& u, int wr, int wc, int fr, int fq) const {
#pragma unroll
        for (int ai = 0; ai < 2; ++ai)
#pragma unroll
            for (int m = 0; m < 4; ++m) { const int row = EPI_ROWS(ai, m);
#pragma unroll
                for (int bj = 0; bj < 2; ++bj) { const int col = EPI_COL(bj);
                    f32x4 g0, g1; unpack8(*(const u32x4*)(GS + (size_t)row * 2048 + col), g0, g1);
                    bf16_t* T1 = row < MT / 2 ? T1A : T1B - (size_t)(MT / 2) * 1024;
                    *(u32x4*)(T1 + (size_t)row * 1024 + col) = pack8(acc[ai][bj][m][0] * g0, acc[ai][bj][m][1] * g1); } }
    }
};
struct EpiRo {
    const bf16_t* GS; const bf16_t* T1A; const bf16_t* T1B; bf16_t* MIX;
    __device__ __forceinline__ void operator()(AccRef acc, const Unit& u, int wr, int wc, int fr, int fq) const {
#pragma unroll
        for (int ai = 0; ai < 2; ++ai)
#pragma unroll
            for (int m = 0; m < 4; ++m) { const int row = EPI_ROWS(ai, m);
#pragma unroll
                for (int bj = 0; bj < 2; ++bj) { const int col = EPI_COL(bj);
                    const bf16_t* T1 = row < MT / 2 ? T1A : T1B - (size_t)(MT / 2) * 1024;
                    f32x4 g0, g1, t0, t1; unpack8(*(const u32x4*)(GS + (size_t)row * 2048 + 1024 + col), g0, g1); unpack8(*(const u32x4*)(T1 + (size_t)row * 1024 + col), t0, t1);
                    *(u32x4*)(MIX + (size_t)row * 1024 + col) = pack8(t0 + acc[ai][bj][m][0] * g0, t1 + acc[ai][bj][m][1] * g1); } }
    }
};
struct EpiRes {
    const float* baseP; const float* baseS; float* out; const float* gate;
    __device__ __forceinline__ void operator()(AccRef acc, const Unit& u, int wr, int wc, int fr, int fq) const {
        const int r0 = u.pm * 256; const int sq = seq_of_row(r0);
        const float* base = r0 < MP ? baseP : baseS - (size_t)MP * 1024;
#pragma unroll
        for (int bj = 0; bj < 2; ++bj) { const int col = EPI_COL(bj);
            const f32x4 g0 = *(const f32x4*)(gate + sq * 6144 + col), g1 = *(const f32x4*)(gate + sq * 6144 + col + 4);
#pragma unroll
            for (int ai = 0; ai < 2; ++ai)
#pragma unroll
                for (int m = 0; m < 4; ++m) { const int row = EPI_ROWS(ai, m);
                    const float* bp = base + (size_t)row * 1024 + col; float* op = out + (size_t)row * 1024 + col;
                    const f32x4 a = *(const f32x4*)bp + acc[ai][bj][m][0] * g0, b = *(const f32x4*)(bp + 4) + acc[ai][bj][m][1] * g1;
                    *(f32x4*)op = a; *(f32x4*)(op + 4) = b; } }
    }
};
struct EpiRes2 {
    const float* baseP; const float* baseS; float* out; const float* mod; const float* gn2; bf16_t* A2; float* SSQ2;
    __device__ __forceinline__ void operator()(AccRef acc, const Unit& u, int wr, int wc, int fr, int fq) const {
        const int r0 = u.pm * 256; const int sq = seq_of_row(r0);
        const float* base = r0 < MP ? baseP : baseS - (size_t)MP * 1024;
        float ss[2][4];
#pragma unroll
        for (int ai = 0; ai < 2; ++ai)
#pragma unroll
            for (int m = 0; m < 4; ++m) ss[ai][m] = 0.f;
#pragma unroll
        for (int bj = 0; bj < 2; ++bj) { const int col = EPI_COL(bj);
            const f32x4 g0 = *(const f32x4*)(mod + sq * 6144 + 2048 + col), g1 = *(const f32x4*)(mod + sq * 6144 + 2048 + col + 4);
            const f32x4 s0 = *(const f32x4*)(gn2 + col) * (*(const f32x4*)(mod + sq * 6144 + 4096 + col) + 1.0f), s1 = *(const f32x4*)(gn2 + col + 4) * (*(const f32x4*)(mod + sq * 6144 + 4096 + col + 4) + 1.0f);
#pragma unroll
            for (int ai = 0; ai < 2; ++ai)
#pragma unroll
                for (int m = 0; m < 4; ++m) { const int row = EPI_ROWS(ai, m);
                    const float* bp = base + (size_t)row * 1024 + col; float* op = out + (size_t)row * 1024 + col;
                    const f32x4 a = *(const f32x4*)bp + acc[ai][bj][m][0] * g0, b = *(const f32x4*)(bp + 4) + acc[ai][bj][m][1] * g1;
                    *(f32x4*)op = a; *(f32x4*)(op + 4) = b;
                    *(u32x4*)(A2 + (size_t)row * 1024 + col) = pack8(a * s0, b * s1);
                    ss[ai][m] += (a[0] * a[0] + a[1] * a[1]) + (a[2] * a[2] + a[3] * a[3]) + (b[0] * b[0] + b[1] * b[1]) + (b[2] * b[2] + b[3] * b[3]); } }
#pragma unroll
        for (int ai = 0; ai < 2; ++ai)
#pragma unroll
            for (int m = 0; m < 4; ++m) { const float v = sum_rows4(ss[ai][m]);
                if (fq == 0) atomicAdd(SSQ2 + EPI_ROWS(ai, m), v); }
    }
};
struct EpiFfn {
    bf16_t* H; const float* SSQ2; const float* C2;
    __device__ __forceinline__ void operator()(AccRef acc, const Unit& u, int wr, int wc, int fr, int fq) const {
        const int sq = seq_of_row(u.pm * 256); const float* cp = C2 + (size_t)sq * 5632 + u.pn * 256 + wc * 32 + 8 * fq;
        const f32x4 cu0 = *(const f32x4*)cp, cu1 = *(const f32x4*)(cp + 4), cz0 = *(const f32x4*)(cp + 128), cz1 = *(const f32x4*)(cp + 132);
#pragma unroll
        for (int ai = 0; ai < 2; ++ai)
#pragma unroll
            for (int m = 0; m < 4; ++m) { const int row = EPI_ROWS(ai, m);
                const float rstd = rsqrtf(SSQ2[row] * (1.0f / DM) + EPS);
                f32x4 a, b;
#pragma unroll
                for (int e = 0; e < 4; ++e) { const float u0 = acc[ai][0][m][0][e] * rstd + cu0[e], u1 = acc[ai][0][m][1][e] * rstd + cu1[e];
                    a[e] = u0 * sigmoidf_(u0) * (acc[ai][1][m][0][e] * rstd + cz0[e]); b[e] = u1 * sigmoidf_(u1) * (acc[ai][1][m][1][e] * rstd + cz1[e]); }
                *(u32x4*)(H + (size_t)row * DFF + u.pn * 128 + wc * 32 + 8 * fq) = pack8(a, b); }
    }
};

template <class F>
__device__ __forceinline__ void transpose_items(const float* W, int ldw, int K, int Ndst, bf16_t* WT, F srcmap, const float* gain, LAS float* scr, int gw, int ngw, int lane) {
    const int nblk = Ndst / 32, nitems = (K / 64) * nblk;
    for (int item = gw; item < nitems; item += ngw) {
        const int kb = item / nblk, nb = item % nblk, k0 = 64 * kb, n0 = 32 * nb; const int sc = srcmap(n0);
#pragma unroll 8
        for (int i = 0; i < 32; ++i) { const int kk = 2 * i + (lane >> 5);
            float v = 0.f; if (sc >= 0) { v = W[(size_t)(k0 + kk) * ldw + sc + (lane & 31)]; if (gain) v *= gain[k0 + kk]; }
            scr[kk * 33 + (lane & 31)] = v; }
        asm volatile("s_waitcnt lgkmcnt(0)" ::: "memory");
        const int c = lane & 7;
#pragma unroll
        for (int j = 0; j < 4; ++j) { const int n = (lane >> 3) + 8 * j; const LAS float* s = scr + (8 * c) * 33 + n;
            u32x4 o; o.x = cvtpk(s[0 * 33], s[1 * 33]); o.y = cvtpk(s[2 * 33], s[3 * 33]); o.z = cvtpk(s[4 * 33], s[5 * 33]); o.w = cvtpk(s[6 * 33], s[7 * 33]);
            *(u32x4*)(WT + (size_t)(n0 + n) * K + k0 + 8 * c) = o; }
        asm volatile("s_waitcnt lgkmcnt(0)" ::: "memory");
    }
}

struct Args {
    const float* in[30]; float* out; unsigned char* ws;
};

__device__ __forceinline__ void adaln_row(const float* xrow, const float* gn, const float* sc, const float* sh, bf16_t* orow, int lane) {
    f32x4 v[4]; float s = 0.f;
#pragma unroll
    for (int j = 0; j < 4; ++j) { v[j] = *(const f32x4*)(xrow + 4 * lane + 256 * j); s += (v[j][0] * v[j][0] + v[j][1] * v[j][1]) + (v[j][2] * v[j][2] + v[j][3] * v[j][3]); }
    const float rstd = rsqrtf(sum64q(s) * (1.0f / DM) + EPS);
#pragma unroll
    for (int j = 0; j < 4; ++j) { const int c = 4 * lane + 256 * j;
        const f32x4 g = *(const f32x4*)(gn + c), s1 = *(const f32x4*)(sc + c), h1 = *(const f32x4*)(sh + c);
        const f32x4 o = v[j] * rstd * g * (s1 + 1.0f) + h1;
        u32x2 w; w.x = cvtpk(o[0], o[1]); w.y = cvtpk(o[2], o[3]); *(u32x2*)(orow + c) = w; }
}

constexpr int KP = 104, VP = 72;
constexpr int ATT_K_BYTES = 64 * KP * 2, ATT_V_BYTES = 64 * VP * 2;
__device__ __forceinline__ int crow(int r, int hi) { return (r & 3) + 8 * (r >> 2) + 4 * hi; }
__device__ __forceinline__ void attn_unit(int row0, int T, int h, int qb, const bf16_t* Q, const bf16_t* KN, const bf16_t* KPE, const bf16_t* VT, bf16_t* O, const float* rope, LAS unsigned char* lds) {
    int tid = threadIdx.x; asm volatile("" : "+v"(tid));
    const int lane = tid & 63, wid = __builtin_amdgcn_readfirstlane(tid >> 6), r32 = lane & 31, hi = lane >> 5;
    LAS unsigned char* Kl = lds; LAS unsigned char* Vl = lds + 3 * ATT_K_BYTES; LAS float* wsf = (LAS float*)(lds + 3 * ATT_K_BYTES + 2 * ATT_V_BYTES) + wid * 32;
    typedef __attribute__((address_space(1))) const u32x4 gv4;
    const int kr = tid >> 3, kc = tid & 7;
    const int pr = (tid & 255) >> 2, pc = tid & 3;
    const bf16_t* gk = KN + (size_t)(row0 + kr) * 512 + h * 64 + 8 * kc;
    const bf16_t* gp = KPE + (size_t)(row0 + pr) * 32 + 8 * pc;
    const bf16_t* gv = VT + (size_t)(h * 64 + kr) * MT + row0 + 8 * kc;
    const int lk = (kr * KP + 8 * kc) * 2, lp = (pr * KP + 64 + 8 * pc) * 2, lv = (kr * VP + 8 * kc) * 2;
    const int fi = (r32 & 0x13) | ((r32 & 4) << 1) | ((r32 & 8) >> 1);
    const int koff = (fi * KP + 8 * hi) * 2, voff = (r32 * VP + 8 * hi) * 2;
    u32x4 sk, sp, sv;
    sk = *(gv4*)gk; sv = *(gv4*)gv; if (tid < 256) sp = *(gv4*)gp;
    u32x4 sk1 = *(gv4*)(gk + (size_t)64 * 512), sp1; if (tid < 256) sp1 = *(gv4*)(gp + (size_t)64 * 32);
    const int qrow = row0 + qb * 256 + wid * 32;
    bf16x8 qf[6];
    { const bf16_t* qp = Q + (size_t)(qrow + r32) * 768;
#pragma unroll
      for (int d0 = 0; d0 < 4; ++d0) qf[d0] = *(const bf16x8*)(qp + h * 64 + 16 * d0 + 8 * hi);
#pragma unroll
      for (int d0 = 0; d0 < 2; ++d0) qf[4 + d0] = *(const bf16x8*)(qp + 512 + h * 32 + 16 * d0 + 8 * hi);
      const float* rp = rope + (qb * 256 + wid * 32 + r32) * 32 + 8 * hi;
      f32x4 x1a, x1b, x2a, x2b; unpack8(__builtin_bit_cast(u32x4, qf[4]), x1a, x1b); unpack8(__builtin_bit_cast(u32x4, qf[5]), x2a, x2b);
      const f32x4 ca = *(const f32x4*)rp, cb = *(const f32x4*)(rp + 4), sa = *(const f32x4*)(rp + 16), sb = *(const f32x4*)(rp + 20);
      qf[4] = __builtin_bit_cast(bf16x8, pack8(x1a * ca - x2a * sa, x1b * cb - x2b * sb));
      qf[5] = __builtin_bit_cast(bf16x8, pack8(x2a * ca + x1a * sa, x2b * cb + x1b * sb)); }
    f32x16 o0, o1, negm;
#pragma unroll
    for (int r = 0; r < 16; ++r) { o0[r] = 0.f; o1[r] = 0.f; negm[r] = 0.f; }
    float mhat = 0.f, lrun = 0.f;
    const int ntiles = T / 64;
    *(LAS u32x4*)(Kl + lk) = sk; *(LAS u32x4*)(Vl + lv) = sv; if (tid < 256) *(LAS u32x4*)(Kl + lp) = sp;
    *(LAS u32x4*)(Kl + ATT_K_BYTES + lk) = sk1; if (tid < 256) *(LAS u32x4*)(Kl + ATT_K_BYTES + lp) = sp1;
    __syncthreads();
#define ATT_QK(P0, P1, KB) do { _Pragma("unroll") for (int d0 = 0; d0 < 6; ++d0) { \
        const bf16x8 k0_ = *(const LAS bf16x8*)((KB) + d0 * 32), k1_ = *(const LAS bf16x8*)((KB) + 32 * KP * 2 + d0 * 32); \
        if (d0 == 0) { P0 = __builtin_amdgcn_mfma_f32_32x32x16_bf16(k0_, qf[0], negm, 0, 0, 0); P1 = __builtin_amdgcn_mfma_f32_32x32x16_bf16(k1_, qf[0], negm, 0, 0, 0); } \
        else { P0 = __builtin_amdgcn_mfma_f32_32x32x16_bf16(k0_, qf[d0], P0, 0, 0, 0); P1 = __builtin_amdgcn_mfma_f32_32x32x16_bf16(k1_, qf[d0], P1, 0, 0, 0); } } } while (0)
    const bool ahead = ((wid ^ (wid >> 2)) & 1) != 0;
    f32x16 p0, p1, n0, n1;
    if (ahead) ATT_QK(p0, p1, Kl + koff);
    int kcur = 0, knxt = 1, knn = 2;
    for (int t = 0; t < ntiles; ++t) {
        const bool has1 = (t + 1 < ntiles), has2 = (t + 2 < ntiles);
        if (has2) { sk = *(gv4*)(gk + (size_t)(t + 2) * 64 * 512); if (tid < 256) sp = *(gv4*)(gp + (size_t)(t + 2) * 64 * 32); }
        if (has1) sv = *(gv4*)(gv + (t + 1) * 64);
        if (!ahead) { __builtin_amdgcn_s_setprio(1); ATT_QK(p0, p1, Kl + kcur * ATT_K_BYTES + koff); __builtin_amdgcn_s_setprio(0); }
        const LAS unsigned char* vb = Vl + (t & 1) * ATT_V_BYTES + voff;
        asm volatile("s_nop 15\n\ts_nop 7" : "+v"(p0), "+v"(p1));
        float rm;
        { float a = max3f(p0[0], p0[1], p1[0]), b = max3f(p0[2], p0[3], p1[1]); a = max3f(a, p1[2], p1[3]);
#pragma unroll
          for (int r = 4; r < 16; r += 4) { a = max3f(a, p0[r], p0[r + 1]); b = max3f(b, p0[r + 2], p0[r + 3]); a = max3f(a, p1[r], p1[r + 1]); b = max3f(b, p1[r + 2], p1[r + 3]); }
          rm = max3f(a, b, b);
          auto rr = __builtin_amdgcn_permlane32_swap(__float_as_uint(rm), __float_as_uint(rm), false, false);
          rm = max3f(__uint_as_float(rr[0]), __uint_as_float(rr[1]), rm); }
        const bool first = (t == 0);
        if (first || __any(rm > 8.0f)) {
            const float dl = first ? rm : fmaxf(rm, 0.f);
            mhat += dl;
#pragma unroll
            for (int r = 0; r < 16; ++r) { p0[r] -= dl; p1[r] -= dl; negm[r] = -mhat; }
            if (!first) {
                const float f = __builtin_amdgcn_exp2f(-dl); lrun *= f;
                if (hi == 0) wsf[r32] = f;
                asm volatile("s_waitcnt lgkmcnt(0)" ::: "memory");
#pragma unroll
                for (int r = 0; r < 16; ++r) { const float ff = wsf[crow(r, hi)]; o0[r] *= ff; o1[r] *= ff; }
            }
        }
        f32x2 ls2 = {0.f, 0.f};
#pragma unroll
        for (int r = 0; r < 16; r += 2) { p0[r] = __builtin_amdgcn_exp2f(p0[r]); p0[r + 1] = __builtin_amdgcn_exp2f(p0[r + 1]); p1[r] = __builtin_amdgcn_exp2f(p1[r]); p1[r + 1] = __builtin_amdgcn_exp2f(p1[r + 1]);
            ls2 += (f32x2){p0[r], p0[r + 1]}; ls2 += (f32x2){p1[r], p1[r + 1]}; }
        lrun += ls2[0] + ls2[1];
        __builtin_amdgcn_s_setprio(1);
        if (ahead && has1) ATT_QK(n0, n1, Kl + knxt * ATT_K_BYTES + koff);
        u32x4 pw[4];
        pw[0] = (u32x4){cvtpk(p0[0], p0[1]), cvtpk(p0[2], p0[3]), cvtpk(p0[4], p0[5]), cvtpk(p0[6], p0[7])};
        pw[1] = (u32x4){cvtpk(p0[8], p0[9]), cvtpk(p0[10], p0[11]), cvtpk(p0[12], p0[13]), cvtpk(p0[14], p0[15])};
        pw[2] = (u32x4){cvtpk(p1[0], p1[1]), cvtpk(p1[2], p1[3]), cvtpk(p1[4], p1[5]), cvtpk(p1[6], p1[7])};
        pw[3] = (u32x4){cvtpk(p1[8], p1[9]), cvtpk(p1[10], p1[11]), cvtpk(p1[12], p1[13]), cvtpk(p1[14], p1[15])};
#pragma unroll
        for (int j = 0; j < 4; ++j) {
            const bf16x8 v0 = *(const LAS bf16x8*)(vb + j * 32), v1 = *(const LAS bf16x8*)(vb + 32 * VP * 2 + j * 32);
            const bf16x8 pa = __builtin_bit_cast(bf16x8, pw[j]);
            o0 = __builtin_amdgcn_mfma_f32_32x32x16_bf16(pa, v0, o0, 0, 0, 0);
            o1 = __builtin_amdgcn_mfma_f32_32x32x16_bf16(pa, v1, o1, 0, 0, 0);
        }
        __builtin_amdgcn_s_setprio(0);
        if (has2) { *(LAS u32x4*)(Kl + knn * ATT_K_BYTES + lk) = sk; if (tid < 256) *(LAS u32x4*)(Kl + knn * ATT_K_BYTES + lp) = sp; }
        if (has1) *(LAS u32x4*)(Vl + ((t + 1) & 1) * ATT_V_BYTES + lv) = sv;
        __syncthreads();
        if (ahead) { p0 = n0; p1 = n1; }
        { const int tmp = kcur; kcur = knxt; knxt = knn; knn = tmp; }
    }
#undef ATT_QK
    { auto rr = __builtin_amdgcn_permlane32_swap(__float_as_uint(lrun), __float_as_uint(lrun), false, false); lrun = __uint_as_float(rr[0]) + __uint_as_float(rr[1]); }
    if (hi == 0) wsf[r32] = 1.0f / lrun;
    asm volatile("s_waitcnt lgkmcnt(0)" ::: "memory");
#pragma unroll
    for (int r = 0; r < 16; ++r) { const int q = crow(r, hi); const float f = wsf[q];
        bf16_t* op = O + (size_t)(qrow + q) * 512 + h * 64 + r32;
        op[0] = (bf16_t)(cvtpk(o0[r] * f, 0.f) & 0xffffu); op[32] = (bf16_t)(cvtpk(o1[r] * f, 0.f) & 0xffffu); }
    __syncthreads();
}

constexpr int SC_CH = 16;
constexpr int SC_BUF_FLOATS = 6 * SC_CH * 64;
constexpr int SC_YSTEP = 8 * 8 * 2 + 4;
typedef __attribute__((address_space(1))) const u32x4 g_u32x4;
typedef __attribute__((address_space(1))) const f32x4 g_f32x4;
typedef __attribute__((address_space(1))) const bf16_t g_bf16;
struct ScanW { const float *mu, *w0, *wd, *a0, *wa, *kk_, *ka, *rk; };
__device__ __forceinline__ float sum16(float x) { x += dpp_f<0xB1>(x); x += dpp_f<0x4E>(x); x += dpp_f<0x141>(x); x += dpp_f<0x140>(x); return x; }
__device__ __forceinline__ float sum64(float x) { return sum_rows4(sum16(x)); }
__device__ __forceinline__ float mixv(float pm, float p0, float pp, float mu) { return p0 + mu * (0.5f * (pm + pp) - p0); }
#define SC_BAR() do { asm volatile("s_waitcnt lgkmcnt(0)" ::: "memory"); __builtin_amdgcn_s_barrier(); asm volatile("" ::: "memory"); } while (0)
__device__ __forceinline__ void scan_chain(int row0, int T, int h, int dir, const bf16_t* PR, const bf16_t* TA, const ScanW W, bf16_t* Y, float* BON, LAS float* sl) {
    int tid = threadIdx.x; asm volatile("" : "+v"(tid));
    const int lane = tid & 63, wid = __builtin_amdgcn_readfirstlane(tid >> 6);
    const int nchunks = T / SC_CH;
    if (wid >= 4) {
        const int pw = wid - 4, n = lane & 15, q = lane >> 4;
        bf16x8 bd[4][2], ba[4][2];
#pragma unroll
        for (int cb = 0; cb < 4; ++cb)
#pragma unroll
            for (int kh = 0; kh < 2; ++kh) {
                unsigned tw_[4], ta_[4];
#pragma unroll
                for (int i2 = 0; i2 < 4; ++i2) { const int k = 32 * kh + 8 * q + 2 * i2; const int col = h * 64 + 4 * n + cb;
                    tw_[i2] = cvtpk(W.wd[(size_t)(dir * 64 + k) * 512 + col], W.wd[(size_t)(dir * 64 + k + 1) * 512 + col]);
                    ta_[i2] = cvtpk(W.wa[(size_t)(dir * 64 + k) * 512 + col], W.wa[(size_t)(dir * 64 + k + 1) * 512 + col]); }
                bd[cb][kh] = __builtin_bit_cast(bf16x8, (u32x4){tw_[0], tw_[1], tw_[2], tw_[3]}); ba[cb][kh] = __builtin_bit_cast(bf16x8, (u32x4){ta_[0], ta_[1], ta_[2], ta_[3]});
            }
        const int gcol = h * 64 + 4 * n;
        typedef __attribute__((address_space(1))) const u32x2 g_u32x2;
        const f32x4 c_w0 = *(g_f32x4*)(W.w0 + dir * 512 + gcol), c_a0 = *(g_f32x4*)(W.a0 + dir * 512 + gcol), c_kk = *(g_f32x4*)(W.kk_ + gcol), c_ka = *(g_f32x4*)(W.ka + gcol), c_rk = *(g_f32x4*)(W.rk + gcol);
        const f32x4 mu_r = *(g_f32x4*)(W.mu + gcol), mu_k = *(g_f32x4*)(W.mu + 512 + gcol), mu_v = *(g_f32x4*)(W.mu + 1024 + gcol);
        for (int i = 0; i < pw; ++i) SC_BAR();
        for (int c = pw; c < nchunks; c += 4) {
            const int sA = c * SC_CH + n; const int tA = dir ? (T - 1 - sA) : sA;
            const bf16_t* tp = TA + (size_t)(row0 + tA) * 128 + 8 * q;
            const u32x4 ra0 = *(g_u32x4*)tp, ra1 = *(g_u32x4*)(tp + 32), ra2 = *(g_u32x4*)(tp + 64), ra3 = *(g_u32x4*)(tp + 96);
            const int s0 = c * SC_CH + 4 * q;
            const int tlo = dir ? (T - 1 - (s0 + 3)) : s0;
            u32x2 ra_[6], rb_[6], rc_[6];
#pragma unroll
            for (int jr = 0; jr < 6; ++jr) { const int tt = tlo - 1 + jr; const bool ok = (tt >= 0) && (tt < T);
                const bf16_t* pp = PR + (size_t)(row0 + (ok ? tt : 0)) * 1792 + gcol; const u32x2 z2 = {0u, 0u};
                ra_[jr] = ok ? *(g_u32x2*)pp : z2; rb_[jr] = ok ? *(g_u32x2*)(pp + 512) : z2; rc_[jr] = ok ? *(g_u32x2*)(pp + 1024) : z2; }
            SC_BAR();
            f32x4 dw[4], da[4];
#pragma unroll
            for (int cb = 0; cb < 4; ++cb) {
                f32x4 xw = {0.f, 0.f, 0.f, 0.f}, xa = {0.f, 0.f, 0.f, 0.f};
                xw = __builtin_amdgcn_mfma_f32_16x16x32_bf16(__builtin_bit_cast(bf16x8, ra0), bd[cb][0], xw, 0, 0, 0); xw = __builtin_amdgcn_mfma_f32_16x16x32_bf16(__builtin_bit_cast(bf16x8, ra1), bd[cb][1], xw, 0, 0, 0);
                xa = __builtin_amdgcn_mfma_f32_16x16x32_bf16(__builtin_bit_cast(bf16x8, ra2), ba[cb][0], xa, 0, 0, 0); xa = __builtin_amdgcn_mfma_f32_16x16x32_bf16(__builtin_bit_cast(bf16x8, ra3), ba[cb][1], xa, 0, 0, 0);
                dw[cb] = xw; da[cb] = xa;
            }
            SC_BAR();
            LAS float* B = sl + (c % 3) * SC_BUF_FLOATS;
#define UP4(w) ((f32x4){bflo((w).x), bfhi((w).x), bflo((w).y), bfhi((w).y)})
#pragma unroll
            for (int i = 0; i < 4; ++i) {
                u32x2 am, a0_, ap_, bm, b0_, bp_, cm, c0_, cp_;
                if (dir) { am = ra_[3 - i]; a0_ = ra_[4 - i]; ap_ = ra_[5 - i]; bm = rb_[3 - i]; b0_ = rb_[4 - i]; bp_ = rb_[5 - i]; cm = rc_[3 - i]; c0_ = rc_[4 - i]; cp_ = rc_[5 - i]; }
                else     { am = ra_[i]; a0_ = ra_[1 + i]; ap_ = ra_[2 + i]; bm = rb_[i]; b0_ = rb_[1 + i]; bp_ = rb_[2 + i]; cm = rc_[i]; c0_ = rc_[1 + i]; cp_ = rc_[2 + i]; }
                const int ti = dir ? (tlo + 3 - i) : (tlo + i);
                const f32x4 r = UP4(a0_) + mu_r * ((UP4(am) + UP4(ap_)) * 0.5f - UP4(a0_));
                const f32x4 kr = UP4(b0_) + mu_k * ((UP4(bm) + UP4(bp_)) * 0.5f - UP4(b0_));
                const f32x4 vv = UP4(c0_) + mu_v * ((UP4(cm) + UP4(cp_)) * 0.5f - UP4(c0_));
                f32x4 wdec, av, kkr, kd;
                float ss = 0.f, bon = 0.f;
#pragma unroll
                for (int cb = 0; cb < 4; ++cb) {
                    const float e = 0.60653065971263342f * sigmoidf_(c_w0[cb] + dw[cb][i]); wdec[cb] = __expf(-e);
                    av[cb] = sigmoidf_(c_a0[cb] + da[cb][i]);
                    kkr[cb] = kr[cb] * c_kk[cb]; ss += kkr[cb] * kkr[cb];
                    kd[cb] = kr[cb] * (1.0f + (av[cb] - 1.0f) * c_ka[cb]);
                    bon += r[cb] * kd[cb] * c_rk[cb];
                }
                ss = sum16(ss); bon = sum16(bon);
                const f32x4 kk = kkr * rsqrtf(ss + 1e-12f);
                const int st = 4 * q + i;
                *(LAS f32x4*)(B + (0 * SC_CH + st) * 64 + 4 * n) = wdec; *(LAS f32x4*)(B + (1 * SC_CH + st) * 64 + 4 * n) = kk * av; *(LAS f32x4*)(B + (2 * SC_CH + st) * 64 + 4 * n) = kd;
                *(LAS f32x4*)(B + (3 * SC_CH + st) * 64 + 4 * n) = kk;   *(LAS f32x4*)(B + (4 * SC_CH + st) * 64 + 4 * n) = r;       *(LAS f32x4*)(B + (5 * SC_CH + st) * 64 + 4 * n) = vv;
                if (n == 0) BON[((size_t)dir * MT + row0 + ti) * 8 + h] = bon;
                if (i == 1 || i == 3) SC_BAR();
            }
#undef UP4
        }
        for (int i = 0; i < 4 - pw; ++i) SC_BAR();
    } else {
        const int g = lane >> 3, j = lane & 7, v0 = 16 * wid + 2 * g;
        LAS float* ypart = sl + 3 * SC_BUF_FLOATS + wid * (SC_CH * SC_YSTEP);
        f32x2 S0[4], S1[4];
#pragma unroll
        for (int i = 0; i < 4; ++i) { S0[i] = (f32x2){0.f, 0.f}; S1[i] = (f32x2){0.f, 0.f}; }
        SC_BAR(); SC_BAR(); SC_BAR(); SC_BAR();
        for (int c = 0; c < nchunks; ++c) {
            const LAS float* B = sl + (c % 3) * SC_BUF_FLOATS;
            f32x4 Aw0, Aw1, Ab0, Ab1, Ad0, Ad1, Ak0, Ak1, Ar0, Ar1, Bw0, Bw1, Bb0, Bb1, Bd0, Bd1, Bk0, Bk1, Br0, Br1; f32x2 Av, Bv;
#define SC_LD(X, Bp) do { const LAS f32x4* p_ = (const LAS f32x4*)((Bp) + 8 * j); X##w0 = p_[0]; X##w1 = p_[1]; X##b0 = p_[256]; X##b1 = p_[257]; X##d0 = p_[512]; X##d1 = p_[513]; X##k0 = p_[768]; X##k1 = p_[769]; X##r0 = p_[1024]; X##r1 = p_[1025]; \
                X##v = *(const LAS f32x2*)((Bp) + 5 * 1024 + v0); } while (0)
#define SC_STEP(X, st_) do { \
                const f32x2 w_[4] = {{X##w0[0], X##w0[1]}, {X##w0[2], X##w0[3]}, {X##w1[0], X##w1[1]}, {X##w1[2], X##w1[3]}}, b_[4] = {{X##b0[0], X##b0[1]}, {X##b0[2], X##b0[3]}, {X##b1[0], X##b1[1]}, {X##b1[2], X##b1[3]}}, \
                            kd_[4] = {{X##d0[0], X##d0[1]}, {X##d0[2], X##d0[3]}, {X##d1[0], X##d1[1]}, {X##d1[2], X##d1[3]}}, kk_[4] = {{X##k0[0], X##k0[1]}, {X##k0[2], X##k0[3]}, {X##k1[0], X##k1[1]}, {X##k1[2], X##k1[3]}}, \
                            r_[4] = {{X##r0[0], X##r0[1]}, {X##r0[2], X##r0[3]}, {X##r1[0], X##r1[1]}, {X##r1[2], X##r1[3]}}; \
                const f32x2 vv = X##v; \
                  \
                f32x2 d0 = S0[0] * kk_[0], d1 = S1[0] * kk_[0]; \
                _Pragma("unroll") for (int i = 1; i < 4; ++i) { d0 += S0[i] * kk_[i]; d1 += S1[i] * kk_[i]; } \
                f32x2 t0[4], t1[4]; \
                _Pragma("unroll") for (int i = 0; i < 4; ++i) { t0[i] = S0[i] * w_[i] + kd_[i] * vv[0]; t1[i] = S1[i] * w_[i] + kd_[i] * vv[1]; } \
                const float sa0 = -sum8(d0[0] + d0[1]), sa1 = -sum8(d1[0] + d1[1]); \
                f32x2 y0 = {0.f, 0.f}, y1 = {0.f, 0.f}; \
                _Pragma("unroll") for (int i = 0; i < 4; ++i) { S0[i] = t0[i] + b_[i] * sa0; S1[i] = t1[i] + b_[i] * sa1; y0 += S0[i] * r_[i]; y1 += S1[i] * r_[i]; } \
                *(LAS f32x2*)(ypart + (st_) * SC_YSTEP + (g * 8 + j) * 2) = (f32x2){y0[0] + y0[1], y1[0] + y1[1]}; } while (0)
            SC_LD(A, B);
#pragma unroll
            for (int st = 0; st < SC_CH; st += 2) {
                SC_LD(B, B + (st + 1) * 64);
                SC_STEP(A, st);
                if (st + 2 < SC_CH) SC_LD(A, B + (st + 2) * 64);
                SC_STEP(B, st + 1);
            }
#undef SC_LD
#undef SC_STEP
#pragma unroll
            for (int u = 0; u < 2; ++u) { const int stp = 2 * j + u;
                const LAS f32x4* yp = (const LAS f32x4*)(ypart + stp * SC_YSTEP + g * 16);
                const f32x4 a = (yp[0] + yp[1]) + (yp[2] + yp[3]);
                const float ya = a[0] + a[2], yb = a[1] + a[3];
                const int s = c * SC_CH + stp; const int t = dir ? (T - 1 - s) : s;
                *(__attribute__((address_space(1))) unsigned*)(Y + (size_t)(row0 + t) * 512 + h * 64 + v0) = cvtpk(ya, yb); }
            SC_BAR();
        }
    }
}

#define RLX_AGENT __ATOMIC_RELAXED, __HIP_MEMORY_SCOPE_AGENT
#define XB_TMO      128
#define XB_XCNT(j)  (256  + 64 * (j))
#define XB_XSUB(j)  (1280 + 64 * (j))
#define XB_XGEN(j)  (2304 + 64 * (j))
#define XB_TOP      3328
#define XB_TOPGEN   3392
#define XCD_BAR_WORDS 3456
#define XB_SPIN_CAP (1u << 18)

__device__ __forceinline__ unsigned xb_ld(unsigned* p)              { return __hip_atomic_load(p, __ATOMIC_RELAXED, __HIP_MEMORY_SCOPE_AGENT); }
__device__ __forceinline__ unsigned xb_add(unsigned* p, unsigned v) { return __hip_atomic_fetch_add(p, v, __ATOMIC_RELAXED, __HIP_MEMORY_SCOPE_AGENT); }
__device__ __forceinline__ unsigned xb_xcc_id() { return (unsigned)__builtin_amdgcn_s_getreg((3 << 11) | 20) & 0xFu; }
#define XB_SPIN(cond, bar) do { unsigned _sp = 0; while (cond) { __builtin_amdgcn_s_sleep(1); \
    if ((++_sp & 255u) == 0u) { if (xb_ld(&(bar)[XB_TMO])) break; if (_sp > XB_SPIN_CAP) { atomicAdd(&(bar)[XB_TMO], 1u); break; } } } } while (0)

struct XcdBarrier {
    unsigned* bar; unsigned x;
    volatile LAS unsigned* st;
};

__device__ __forceinline__ XcdBarrier xcd_barrier_post(unsigned* bar, volatile LAS unsigned* st) {
    XcdBarrier b; b.bar = bar; b.x = xb_xcc_id(); b.st = st;
    if (threadIdx.x == 0) (void)xb_add(&bar[XB_XCNT(b.x)], 1u);
    return b;
}
__device__ __forceinline__ void xcd_barrier_complete(unsigned* bar, unsigned x, unsigned& nloc, unsigned& nx) {
    const unsigned G = gridDim.x * gridDim.y * gridDim.z;
    unsigned sum, cnt, mine, sp = 0u;
    for (;;) {
        sum = 0u; cnt = 0u; mine = 0u;
#pragma unroll
        for (unsigned j = 0; j < 16; ++j) { const unsigned c = xb_ld(&bar[XB_XCNT(j)]); sum += c; cnt += (c > 0u) ? 1u : 0u; mine = (j == x) ? c : mine; }
        if (sum == G) break;
        __builtin_amdgcn_s_sleep(1);
        if ((++sp & 255u) == 0u) { if (xb_ld(&bar[XB_TMO])) break; if (sp > XB_SPIN_CAP) { atomicAdd(&bar[XB_TMO], 1u); break; } }
    }
    nloc = mine > 0u ? mine : 1u; nx = cnt > 0u ? cnt : 1u;
}

__device__ __forceinline__ void xcd_barrier(const XcdBarrier& b) {
    asm volatile("s_waitcnt vmcnt(0)" ::: "memory");
    __syncthreads();
    if (threadIdx.x == 0) {
        unsigned* bar = b.bar;
        __builtin_amdgcn_s_waitcnt(0);
        unsigned nloc = b.st[0], nx = b.st[1];
        if (nloc == 0u) { xcd_barrier_complete(bar, b.x, nloc, nx); b.st[0] = nloc; b.st[1] = nx; }
        const unsigned old = xb_add(&bar[XB_XSUB(b.x)], 1u);
        const unsigned gen = old / nloc;
        if (old + 1u == (gen + 1u) * nloc) {
            __builtin_amdgcn_fence(__ATOMIC_RELEASE, "agent");
            asm volatile("s_waitcnt vmcnt(0)" ::: "memory");
            const unsigned og = xb_add(&bar[XB_TOP], 1u);
            const unsigned tg = og / nx;
            if (og + 1u == (tg + 1u) * nx) xb_add(&bar[XB_TOPGEN], 1u);
            else XB_SPIN(xb_ld(&bar[XB_TOPGEN]) == tg, bar);
            __builtin_amdgcn_fence(__ATOMIC_ACQUIRE, "agent");
            xb_add(&bar[XB_XGEN(b.x)], 1u);
            asm volatile("s_waitcnt vmcnt(0)" ::: "memory");
        } else {
            XB_SPIN(xb_ld(&bar[XB_XGEN(b.x)]) == gen, bar);
            __builtin_amdgcn_fence(__ATOMIC_ACQUIRE, "agent");
            asm volatile("s_waitcnt vmcnt(0)" ::: "memory");
        }
    }
    __syncthreads();
}


constexpr int LDS_BYTES = 147456 + 256;
#ifndef REP_ATT
#define REP_ATT 1
#endif
#ifndef REP_SCAN
#define REP_SCAN 1
#endif
#ifndef REP_P2
#define REP_P2 1
#endif
#ifndef REP_FFN
#define REP_FFN 1
#endif
__global__ void __launch_bounds__(512, 2) fwd_kernel(Args a) {
    extern __shared__ __attribute__((aligned(16))) unsigned char lds_raw[];
    LAS unsigned char* lds = (LAS unsigned char*)lds_raw;
    cg::grid_group grid = cg::this_grid();
    const int G = gridDim.x, bx = blockIdx.x;
    const int vcu = (G % 8 == 0) ? (bx % 8) * (G / 8) + bx / 8 : bx;
    if (threadIdx.x < 2) ((volatile LAS unsigned*)(lds + 147456))[threadIdx.x] = 0u;
    __syncthreads();
    if (bx == 0) { unsigned* bw = (unsigned*)(a.ws + WS_BAR); for (int i = threadIdx.x; i < XCD_BAR_WORDS; i += 512) bw[i] = 0u; }
#define PHASE_BEGIN const __attribute__((address_space(4))) Args* ap = (const __attribute__((address_space(4))) Args*)__builtin_amdgcn_kernarg_segment_ptr(); asm volatile("" : "+s"(ap)); int tid = threadIdx.x; asm volatile("" : "+v"(tid)); const int lane = tid & 63, wave = __builtin_amdgcn_readfirstlane(tid >> 6); \
    unsigned char* ws = ap->ws; asm volatile("" : "+s"(ws)); const int gw = vcu * 8 + wave, ngw = G * 8; (void)lane; (void)gw; (void)ngw;
#define WSP(T, off) ((T*)(ws + (off)))

    {
        PHASE_BEGIN
        LAS float* scr = (LAS float*)lds + wave * (64 * 33);
        transpose_items(ap->in[7], 4512, 1024, NPAD_IN, WSP(bf16_t, WS_WIN), [](int n0) { return n0 < 672 ? n0 : (n0 < 768 ? -1 : n0 - 96); }, nullptr, scr, gw, ngw, lane);
        transpose_items(ap->in[10], 768, 384, 768, WSP(bf16_t, WS_WUQ), [](int n0) { return n0 < 512 ? (n0 >> 6) * 96 + (n0 & 63) : ((n0 - 512) >> 5) * 96 + 64; }, ap->in[8], scr, gw, ngw, lane);
        transpose_items(ap->in[11], 1024, 256, 512, WSP(bf16_t, WS_WK), [](int n0) { return (n0 >> 6) * 128 + (n0 & 63); }, ap->in[9], scr, gw, ngw, lane);
        transpose_items(ap->in[11], 1024, 256, 512, WSP(bf16_t, WS_WV), [](int n0) { return (n0 >> 6) * 128 + 64 + (n0 & 63); }, ap->in[9], scr, gw, ngw, lane);
        transpose_items(ap->in[17], 512, 128, 512, WSP(bf16_t, WS_WG), [](int n0) { return n0; }, nullptr, scr, gw, ngw, lane);
        transpose_items(ap->in[23], 1024, 512, 1024, WSP(bf16_t, WS_WMO), [](int n0) { return n0; }, nullptr, scr, gw, ngw, lane);
        transpose_items(ap->in[24], 1024, 512, 1024, WSP(bf16_t, WS_WRO), [](int n0) { return n0; }, nullptr, scr, gw, ngw, lane);
        transpose_items(ap->in[25], 1024, 1024, 1024, WSP(bf16_t, WS_WOUT), [](int n0) { return n0; }, nullptr, scr, gw, ngw, lane);
        transpose_items(ap->in[27], 5632, 1024, 5632, WSP(bf16_t, WS_WFFI), [](int n0) { const int tl = n0 >> 8, wi = n0 & 255; return wi < 128 ? tl * 128 + wi : 2816 + tl * 128 + (wi - 128); }, nullptr, scr, gw, ngw, lane);
        transpose_items(ap->in[28], 1024, 2816, 1024, WSP(bf16_t, WS_WFFO), [](int n0) { return n0; }, nullptr, scr, gw, ngw, lane);
        { float* z2 = WSP(float, WS_SSQ2); for (int i = bx * 512 + tid; i < MT; i += G * 512) z2[i] = 0.f; }
        float* ROPE = WSP(float, WS_ROPE);
        for (int i = bx * 512 + tid; i < TP * 16; i += G * 512) { const int t = i >> 4, f = i & 15;
            const float inv = exp2f(-(float)f * (13.287712379549449f / 16.0f)); const float ang = (float)t * inv;
            float sn, cs; sincosf(ang, &sn, &cs); ROPE[t * 32 + f] = cs; ROPE[t * 32 + 16 + f] = sn; }
        __syncthreads();
        if (bx < 96) {
            float* MOD = WSP(float, WS_MOD);
            LAS float* scs = (LAS float*)lds;
            LAS float* part = scs + 1024 * 24;
            for (int i = tid; i < NSEQ * 1024; i += 512) { const int r = i >> 10, k = i & 1023; const float c = r < 8 ? ap->in[2][r * 1024 + k] : ap->in[3][(r - 8) * 1024 + k]; scs[k * 24 + r] = c * sigmoidf_(c); }
            __syncthreads();
            const int jc = tid & 63, ks = tid >> 6, jcol = bx * 64 + jc;
            f32x4 acc[6];
#pragma unroll
            for (int r = 0; r < 6; ++r) acc[r] = (f32x4){0.f, 0.f, 0.f, 0.f};
            const float* wp = ap->in[4] + (size_t)(ks * 128) * 6144 + jcol;
#pragma unroll 8
            for (int k = 0; k < 128; ++k) { const float w = wp[(size_t)k * 6144]; const LAS f32x4* sp4 = (const LAS f32x4*)(scs + (ks * 128 + k) * 24);
#pragma unroll
                for (int r = 0; r < 6; ++r) acc[r] += sp4[r] * w; }
#pragma unroll
            for (int r = 0; r < 6; ++r)
#pragma unroll
                for (int e = 0; e < 4; ++e) part[(ks * 24 + 4 * r + e) * 64 + jc] = acc[r][e];
            __syncthreads();
            for (int o = tid; o < 24 * 64; o += 512) { const int r = o >> 6, c = o & 63; float sum = 0.f;
#pragma unroll
                for (int k8 = 0; k8 < 8; ++k8) sum += part[(k8 * 24 + r) * 64 + c];
                MOD[r * 6144 + bx * 64 + c] = sum + ap->in[5][bx * 64 + c]; }
        }
    }
    grid.sync();
    const XcdBarrier xbar = xcd_barrier_post((unsigned*)(a.ws + WS_BAR), (volatile LAS unsigned*)(lds + 147456));
    {
        PHASE_BEGIN
        const float* MOD = WSP(float, WS_MOD); bf16_t* XN = WSP(bf16_t, WS_XN);
        for (int row = gw; row < MT; row += ngw) { const int sq = seq_of_row(row);
            adaln_row(row < MP ? ap->in[0] + (size_t)row * DM : ap->in[1] + (size_t)(row - MP) * DM, ap->in[6], MOD + sq * 6144 + 1024, MOD + sq * 6144, XN + (size_t)row * DM, lane); }
        { const bf16_t* Wf = WSP(bf16_t, WS_WFFI); float* C2 = WSP(float, WS_C2);
          for (int n = gw; n < 5632; n += ngw) {
              f32x4 w0, w1, w2, w3; unpack8(*(const u32x4*)(Wf + (size_t)n * 1024 + 16 * lane), w0, w1); unpack8(*(const u32x4*)(Wf + (size_t)n * 1024 + 16 * lane + 8), w2, w3);
              for (int b = 0; b < NSEQ; ++b) { const float* sp = MOD + b * 6144 + 3072 + 16 * lane;
                  const f32x4 h0 = *(const f32x4*)sp, h1 = *(const f32x4*)(sp + 4), h2 = *(const f32x4*)(sp + 8), h3 = *(const f32x4*)(sp + 12);
                  const f32x4 p = h0 * w0 + h1 * w1 + h2 * w2 + h3 * w3;
                  const float tot = sum64q((p[0] + p[1]) + (p[2] + p[3]));
                  if (lane == 0) C2[b * 5632 + n] = tot; } } }
    }
    xcd_barrier(xbar);
    {
        PHASE_BEGIN
        pg8::Gemm g{WSP(bf16_t, WS_XN), WSP(bf16_t, WS_WIN), MT, NPAD_IN, 1024, 1024, 1024}; pg8::StaticOrder S; S.init(MT, NPAD_IN, G, bx);
        EpiIn E{WSP(bf16_t, WS_PM), WSP(float, WS_SSQ), WSP(bf16_t, WS_KPE), WSP(bf16_t, WS_PR), (bf16_t*)ap->out, WSP(float, WS_ROPE)}; for (int rep = 0; rep < REP_P2; ++rep) pg8::gemm_phase<EpiIn, true>(lds, g, S, E);
    }
    xcd_barrier(xbar);
    { PHASE_BEGIN pg8::Gemm g{WSP(bf16_t, WS_PM), WSP(bf16_t, WS_WUQ), MT, 768, 384, 640, 384}; pg8::StaticOrder S; S.init(MT, 768, G, bx); EpiQ E{WSP(float, WS_SSQ), WSP(bf16_t, WS_Q)}; pg8::gemm_phase<EpiQ, true>(lds, g, S, E); }
    { PHASE_BEGIN pg8::Gemm g{WSP(bf16_t, WS_PM) + 384, WSP(bf16_t, WS_WK), MT, 512, 256, 640, 256}; pg8::StaticOrder S; S.init(MT, 512, G, bx); EpiK E{WSP(float, WS_SSQ), WSP(bf16_t, WS_KN)}; pg8::gemm_phase<EpiK, true>(lds, g, S, E); }
    { PHASE_BEGIN pg8::Gemm g{WSP(bf16_t, WS_WV), WSP(bf16_t, WS_PM) + 384, 512, MT, 256, 256, 640}; pg8::StaticOrder S; S.init(512, MT, G, bx); EpiVT E{WSP(float, WS_SSQ), WSP(bf16_t, WS_VT)}; pg8::gemm_phase<EpiVT, true>(lds, g, S, E); }
    xcd_barrier(xbar);
    {
        PHASE_BEGIN
        const bf16_t *Qb = WSP(bf16_t, WS_Q), *KN = WSP(bf16_t, WS_KN), *KPE = WSP(bf16_t, WS_KPE), *VT = WSP(bf16_t, WS_VT); bf16_t* Ob = WSP(bf16_t, WS_O); const float* ROPE = WSP(float, WS_ROPE);
        for (int rep = 0; rep < REP_ATT; ++rep) {
        for (int i = vcu; i < 2048; i += G) { const int bh = i >> 5, qb = i & 31; attn_unit((bh >> 3) * TP, TP, bh & 7, qb, Qb, KN, KPE, VT, Ob, ROPE, lds); }
        for (int i = vcu; i < 1024; i += G) { const int bh = i >> 3, qb = i & 7; attn_unit(MP + (bh >> 3) * TS, TS, bh & 7, qb, Qb, KN, KPE, VT, Ob, ROPE, lds); }
        }
    }
    {
        PHASE_BEGIN
        const bf16_t* PR = WSP(bf16_t, WS_PR); bf16_t* TA = WSP(bf16_t, WS_TA); bf16_t* SG = WSP(bf16_t, WS_SG); const float* mu = ap->in[12];
        for (int i = bx * 512 + tid; i < MT * 32; i += G * 512) { const int row = i >> 5, c8 = (i & 31) * 8; const int t = pos_of_row(row), T = len_of_row(row);
            const bf16_t* pp = PR + (size_t)row * 1792 + 1536 + c8; const u32x4 z = {0u, 0u, 0u, 0u};
            const u32x4 x0 = *(const u32x4*)pp, xm = t > 0 ? *(const u32x4*)(pp - 1792) : z, xp = t < T - 1 ? *(const u32x4*)(pp + 1792) : z;
            f32x4 a0_, a1_, m0_, m1_, p0_, p1_; unpack8(x0, a0_, a1_); unpack8(xm, m0_, m1_); unpack8(xp, p0_, p1_);
            const f32x4 mu0 = *(const f32x4*)(mu + 1536 + c8), mu1 = *(const f32x4*)(mu + 1536 + c8 + 4);
            f32x4 r0 = a0_ + mu0 * ((m0_ + p0_) * 0.5f - a0_), r1 = a1_ + mu1 * ((m1_ + p1_) * 0.5f - a1_);
            if (c8 < 64) {
#pragma unroll
                for (int e = 0; e < 4; ++e) { r0[e] = tanh_fast(r0[e]); r1[e] = tanh_fast(r1[e]); } }
            else if (c8 >= 128) {
#pragma unroll
                for (int e = 0; e < 4; ++e) { r0[e] = sigmoidf_(r0[e]); r1[e] = sigmoidf_(r1[e]); } }
            if (c8 < 128) *(u32x4*)(TA + (size_t)row * 128 + c8) = pack8(r0, r1); else *(u32x4*)(SG + (size_t)row * 128 + (c8 - 128)) = pack8(r0, r1); }
    }
    xcd_barrier(xbar);
    {
        PHASE_BEGIN
        const ScanW W{ap->in[12], ap->in[13], ap->in[14], ap->in[15], ap->in[16], ap->in[18], ap->in[19], ap->in[20]};
        for (int rep = 0; rep < REP_SCAN; ++rep)
        for (int i = bx; i < 256; i += G)
        for (int sub = 0; sub < (i < 128 ? 1 : 2); ++sub) {
            int row0, T, h, dir;
            if (i < 128) { const int b = i >> 4; h = (i >> 1) & 7; dir = i & 1; row0 = b * TP; T = TP; }
            else { const int k = 2 * (i - 128) + sub; const int b = k >> 4; h = (k >> 1) & 7; dir = k & 1; row0 = MP + b * TS; T = TS; }
            scan_chain(row0, T, h, dir, WSP(bf16_t, WS_PR), WSP(bf16_t, WS_TA), W, dir ? WSP(bf16_t, WS_Y1) : WSP(bf16_t, WS_Y0), WSP(float, WS_BON), (LAS float*)lds);
            __syncthreads();
        }
    }
    if (G > 128 && bx >= 128) { PHASE_BEGIN pg8::Gemm g{WSP(bf16_t, WS_O), WSP(bf16_t, WS_WMO), MT, 1024, 512, 512, 512}; pg8::StaticOrder S; S.init(MT, 1024, G - 128, bx - 128);
        EpiMo E{(const bf16_t*)ap->out, WSP(bf16_t, WS_T1A), WSP(bf16_t, WS_T1B)}; pg8::gemm_phase<EpiMo, true>(lds, g, S, E); }
    if (G > 128 && bx >= 128) { PHASE_BEGIN pg8::Gemm g{WSP(bf16_t, WS_SG), WSP(bf16_t, WS_WG), MT, 512, 128, 128, 128}; pg8::StaticOrder S; S.init(MT, 512, G - 128, bx - 128); EpiG E{WSP(bf16_t, WS_G)}; pg8::gemm_phase<EpiG, true>(lds, g, S, E); }
    else if (G <= 128) { PHASE_BEGIN pg8::Gemm g{WSP(bf16_t, WS_SG), WSP(bf16_t, WS_WG), MT, 512, 128, 128, 128}; pg8::StaticOrder S; S.init(MT, 512, G, bx); EpiG E{WSP(bf16_t, WS_G)}; pg8::gemm_phase<EpiG, true>(lds, g, S, E); }
    if (G <= 128) { PHASE_BEGIN pg8::Gemm g{WSP(bf16_t, WS_O), WSP(bf16_t, WS_WMO), MT, 1024, 512, 512, 512}; pg8::StaticOrder S; S.init(MT, 1024, G, bx);
        EpiMo E{(const bf16_t*)ap->out, WSP(bf16_t, WS_T1A), WSP(bf16_t, WS_T1B)}; pg8::gemm_phase<EpiMo, true>(lds, g, S, E); }
    xcd_barrier(xbar);
    {
        PHASE_BEGIN
        const bf16_t *Y0 = WSP(bf16_t, WS_Y0), *Y1 = WSP(bf16_t, WS_Y1); const float* BON = WSP(float, WS_BON); const bf16_t* PR = WSP(bf16_t, WS_PR); bf16_t* Gb = WSP(bf16_t, WS_G);
        const float *mu = ap->in[12], *lnw = ap->in[21], *lnb = ap->in[22];
        for (int row = gw; row < MT; row += ngw) {
            const int hh = lane >> 3, c0 = lane * 8; const int t = pos_of_row(row), T = len_of_row(row);
            f32x4 ya, yb, yc, yd; unpack8(*(const u32x4*)(Y0 + (size_t)row * 512 + c0), ya, yb); unpack8(*(const u32x4*)(Y1 + (size_t)row * 512 + c0), yc, yd);
            ya = ya + yc; yb = yb + yd;
            float s = (ya[0] + ya[1]) + (ya[2] + ya[3]) + (yb[0] + yb[1]) + (yb[2] + yb[3]);
            s = sum8(s);
            const float mean = s * (1.0f / 64.0f); ya = ya - mean; yb = yb - mean;
            float q = (ya[0] * ya[0] + ya[1] * ya[1]) + (ya[2] * ya[2] + ya[3] * ya[3]) + (yb[0] * yb[0] + yb[1] * yb[1]) + (yb[2] * yb[2] + yb[3] * yb[3]);
            q = sum8(q);
            const float rstd = rsqrtf(q * (1.0f / 64.0f) + LNX_EPS);
            const bf16_t* pp = PR + (size_t)row * 1792 + 1024 + c0; const u32x4 z = {0u, 0u, 0u, 0u};
            const u32x4 x0 = *(const u32x4*)pp, xm = t > 0 ? *(const u32x4*)(pp - 1792) : z, xp = t < T - 1 ? *(const u32x4*)(pp + 1792) : z;
            f32x4 a0_, a1_, m0_, m1_, p0_, p1_; unpack8(x0, a0_, a1_); unpack8(xm, m0_, m1_); unpack8(xp, p0_, p1_);
            const f32x4 mu0 = *(const f32x4*)(mu + 1024 + c0), mu1 = *(const f32x4*)(mu + 1024 + c0 + 4);
            const f32x4 v0 = a0_ + mu0 * ((m0_ + p0_) * 0.5f - a0_), v1 = a1_ + mu1 * ((m1_ + p1_) * 0.5f - a1_);
            const float bon = BON[(size_t)row * 8 + hh] + BON[((size_t)MT + row) * 8 + hh];
            const f32x4 lw0 = *(const f32x4*)(lnw + c0), lw1 = *(const f32x4*)(lnw + c0 + 4), lb0 = *(const f32x4*)(lnb + c0), lb1 = *(const f32x4*)(lnb + c0 + 4);
            f32x4 g0, g1; unpack8(*(const u32x4*)(Gb + (size_t)row * 512 + c0), g0, g1);
            const f32x4 o0 = (ya * rstd * lw0 + lb0 + v0 * bon) * g0, o1 = (yb * rstd * lw1 + lb1 + v1 * bon) * g1;
            *(u32x4*)(Gb + (size_t)row * 512 + c0) = pack8(o0, o1);
        }
    }
    xcd_barrier(xbar);
    { PHASE_BEGIN pg8::Gemm g{WSP(bf16_t, WS_G), WSP(bf16_t, WS_WRO), MT, 1024, 512, 512, 512}; pg8::StaticOrder S; S.init(MT, 1024, G, bx); EpiRo E{(const bf16_t*)ap->out, WSP(bf16_t, WS_T1A), WSP(bf16_t, WS_T1B), WSP(bf16_t, WS_MIX)}; pg8::gemm_phase<EpiRo, true>(lds, g, S, E); }
    xcd_barrier(xbar);
    { PHASE_BEGIN pg8::Gemm g{WSP(bf16_t, WS_MIX), WSP(bf16_t, WS_WOUT), MT, 1024, 1024, 1024, 1024}; pg8::StaticOrder S; S.init(MT, 1024, G, bx); EpiRes2 E{ap->in[0], ap->in[1], ap->out, WSP(float, WS_MOD), ap->in[26], WSP(bf16_t, WS_XN2), WSP(float, WS_SSQ2)}; pg8::gemm_phase<EpiRes2, true>(lds, g, S, E); }
    xcd_barrier(xbar);
    { PHASE_BEGIN pg8::Gemm g{WSP(bf16_t, WS_XN2), WSP(bf16_t, WS_WFFI), MT, 5632, 1024, 1024, 1024}; pg8::StaticOrder S; S.init(MT, 5632, G, bx); EpiFfn E{WSP(bf16_t, WS_H), WSP(float, WS_SSQ2), WSP(float, WS_C2)}; for (int rep = 0; rep < REP_FFN; ++rep) pg8::gemm_phase<EpiFfn, true>(lds, g, S, E); }
    xcd_barrier(xbar);
    { PHASE_BEGIN pg8::Gemm g{WSP(bf16_t, WS_H), WSP(bf16_t, WS_WFFO), MT, 1024, DFF, DFF, DFF}; pg8::StaticOrder S; S.init(MT, 1024, G, bx); EpiRes E{ap->out, ap->out + (size_t)MP * 1024, ap->out, WSP(float, WS_MOD) + 5120}; pg8::gemm_phase<EpiRes, true>(lds, g, S, E); }
    xcd_barrier(xbar);
    {
        PHASE_BEGIN
        const float* fn = ap->in[29];
        for (int row = gw; row < MT; row += ngw) {
            float* xr = ap->out + (size_t)row * DM; f32x4 v[4]; float s = 0.f;
#pragma unroll
            for (int j = 0; j < 4; ++j) { v[j] = *(const f32x4*)(xr + 4 * lane + 256 * j); s += (v[j][0] * v[j][0] + v[j][1] * v[j][1]) + (v[j][2] * v[j][2] + v[j][3] * v[j][3]); }
            const float rstd = rsqrtf(sum64q(s) * (1.0f / DM) + EPS);
#pragma unroll
            for (int j = 0; j < 4; ++j) { const f32x4 g = *(const f32x4*)(fn + 4 * lane + 256 * j); *(f32x4*)(xr + 4 * lane + 256 * j) = v[j] * rstd * g; }
        }
    }
}

extern "C" void kernel_launch(void* const* d_in, const int* in_sizes, int n_in, void* d_out, int out_size, void* d_ws, size_t ws_size, hipStream_t stream) {
    static int grid = 0;
    if (grid == 0) {
        if (n_in != 30 || out_size != MT * DM || ws_size < WS_END) { fprintf(stderr, "kernel_launch: unexpected shapes (n_in %d out %d ws %zu)\n", n_in, out_size, ws_size); grid = -1; return; }
        int dev = 0, cus = 0, per_cu = 0;
        hipGetDevice(&dev); hipDeviceGetAttribute(&cus, hipDeviceAttributeMultiprocessorCount, dev);
        if (hipFuncSetAttribute((const void*)fwd_kernel, hipFuncAttributeMaxDynamicSharedMemorySize, LDS_BYTES) != hipSuccess) { fprintf(stderr, "kernel_launch: hipFuncSetAttribute failed\n"); grid = -1; return; }
        hipOccupancyMaxActiveBlocksPerMultiprocessor(&per_cu, (const void*)fwd_kernel, 512, LDS_BYTES);
        (void)hipGetLastError();
        if (per_cu < 1) per_cu = 1;
        grid = cus * 1;
        fprintf(stderr, "kernel_launch: cus %d per_cu %d grid %d\n", cus, per_cu, grid);
    }
    if (grid < 0) return;
    Args a{};
    for (int i = 0; i < 30; ++i) a.in[i] = (const float*)d_in[i];
    a.out = (float*)d_out; a.ws = (unsigned char*)d_ws;
    void* args[] = {&a};
    hipError_t e = hipLaunchCooperativeKernel((const void*)fwd_kernel, dim3(grid), dim3(512), args, LDS_BYTES, stream);
    if (e != hipSuccess) fprintf(stderr, "cooperative launch failed: %s (grid %d)\n", hipGetErrorString(e), grid);
}
```
